# Optimizing an MI355X kernel written in HIP

```python
import jax, jax.numpy as jnp
from jax import lax
import numpy as np

D_MODEL = 2048
BATCH = 8
SEQ = 2048
DEPTH = 1

CHUNK = 64
N_MEM = 256

POOL_WINDOWS = (2, 4, 8, 16)
N_POOL_GROUPS = len(POOL_WINDOWS)
POOL_GROUP_DIM = D_MODEL // 16
POOL_WIDTH = N_POOL_GROUPS * POOL_GROUP_DIM
SB_HEAD_DIM = D_MODEL // 16
SB_HEADS = 8
SB_WIDTH = SB_HEADS * SB_HEAD_DIM
Q_BLOCK = 128
XA_HEAD_DIM = D_MODEL // 16
XA_HEADS = 4
XA_WIDTH = XA_HEADS * XA_HEAD_DIM
N_BRANCHES = 3
IN_SPLITS = (POOL_WIDTH, SB_WIDTH, SB_WIDTH, SB_WIDTH, XA_WIDTH, N_BRANCHES * D_MODEL)
IN_WIDTH = sum(IN_SPLITS)
N_EXPERTS = 32
TOP_K = 4
D_FF = D_MODEL
SWIGLU_LIMIT = 7.0
SWIGLU_ALPHA = 1.702
ROUTE_BLOCK = 128
EPS = 1e-5

kernel_name = "hybrid_pool_stickbreak_memxattn_moe"


def rmsnorm(x, g):
    xf = x.astype(jnp.float32)
    y = xf * lax.rsqrt(jnp.mean(xf * xf, axis=-1, keepdims=True) + EPS)
    return (y * g.astype(jnp.float32)).astype(x.dtype)


def pool_mixer(u, w_group, scale):
    B, S, _ = u.shape
    uf = u.astype(jnp.float32).reshape(B, S, N_POOL_GROUPS, POOL_GROUP_DIM)
    csum = jnp.cumsum(uf, axis=1)
    n_seen = jnp.arange(1, S + 1, dtype=jnp.float32)
    diffs = []
    for g, w in enumerate(POOL_WINDOWS):
        c = csum[:, :, g]
        lagged = jnp.pad(c[:, :S - w], ((0, 0), (w, 0), (0, 0)))
        mean = (c - lagged) / jnp.minimum(n_seen, float(w))[None, :, None]
        diffs.append(mean - uf[:, :, g])
    d = jnp.stack(diffs, axis=2).astype(u.dtype)
    y = jnp.einsum('bsgc,gcd->bsgd', d, w_group)
    return y.reshape(B, S, POOL_WIDTH) * scale


def stick_breaking_attention(q, k, v):
    B, S, H, Dh = q.shape
    scale = 1.0 / float(np.sqrt(Dh))
    outs = []
    for i in range(S // Q_BLOCK):
        t0, t1 = i * Q_BLOCK, (i + 1) * Q_BLOCK
        qb, kb, vb = q[:, t0:t1], k[:, :t1], v[:, :t1]
        z = jnp.einsum('bqhd,bkhd->bhqk', qb, kb).astype(jnp.float32) * scale
        strict = jnp.arange(t1)[None, :] < jnp.arange(t0, t1)[:, None]
        log_fail = jnp.where(strict, jax.nn.log_sigmoid(-z), 0.0)
        log_after = lax.cumsum(log_fail, axis=3, reverse=True) - log_fail
        a = jnp.where(strict, jnp.exp(jax.nn.log_sigmoid(z) + log_after), 0.0)
        outs.append(jnp.einsum('bhqk,bkhd->bqhd', a.astype(v.dtype), vb))
    return jnp.concatenate(outs, axis=1)


def memory_attention(q, mem_n, w_kv):
    B, S, _ = q.shape
    M = mem_n.shape[1]
    k, v = jnp.split(mem_n @ w_kv, 2, axis=-1)
    qh = q.reshape(B, S, XA_HEADS, XA_HEAD_DIM)
    kh = k.reshape(B, M, XA_HEADS, XA_HEAD_DIM)
    vh = v.reshape(B, M, XA_HEADS, XA_HEAD_DIM)
    s = jnp.einsum('bqhd,bmhd->bhqm', qh, kh).astype(jnp.float32) / float(np.sqrt(XA_HEAD_DIM))
    p = jax.nn.softmax(s, axis=-1).astype(v.dtype)
    return jnp.einsum('bhqm,bmhd->bqhd', p, vh).reshape(B, S, XA_WIDTH)


def clamped_swiglu(gate, up):
    gate = jnp.minimum(gate, SWIGLU_LIMIT)
    up = jnp.clip(up, -SWIGLU_LIMIT, SWIGLU_LIMIT)
    return gate * jax.nn.sigmoid(SWIGLU_ALPHA * gate) * (up + 1.0)


def moe_ffn(xn, w_router, b_router, w_gate, b_gate, w_up, b_up, w_down, b_down):
    T, D = xn.shape
    TK = T * TOP_K
    logits = (xn @ w_router + b_router).astype(jnp.float32)
    top_val, top_idx = lax.top_k(logits, TOP_K)
    probs = jax.nn.softmax(top_val, axis=-1)
    e_flat = top_idx.reshape(-1)
    tok_flat = jnp.broadcast_to(jnp.arange(T, dtype=jnp.int32)[:, None], (T, TOP_K)).reshape(-1)
    g_flat = probs.reshape(-1)
    order = jnp.argsort(e_flat)
    e_s, tok_s, g_s = e_flat[order], tok_flat[order], g_flat[order]
    counts = jnp.bincount(e_flat, length=N_EXPERTS)
    padded = (counts + ROUTE_BLOCK - 1) // ROUTE_BLOCK * ROUTE_BLOCK
    grp_start = jnp.cumsum(counts) - counts
    pad_end = jnp.cumsum(padded)
    pad_start = pad_end - padded
    dest = pad_start[e_s] + (jnp.arange(TK) - grp_start[e_s])
    n_rows = TK + N_EXPERTS * ROUTE_BLOCK
    n_blk = n_rows // ROUTE_BLOCK
    rows_tok = jnp.full((n_rows,), T, jnp.int32).at[dest].set(tok_s)
    rows_gate = jnp.zeros((n_rows,), jnp.float32).at[dest].set(g_s)
    blk_expert = jnp.minimum(
        jnp.searchsorted(pad_end, jnp.arange(n_blk) * ROUTE_BLOCK, side='right'), N_EXPERTS - 1)
    x_pad = jnp.concatenate([xn, jnp.zeros((1, D), xn.dtype)], axis=0)

    def run_block(args):
        tok, e = args
        xb = x_pad[tok]
        h = clamped_swiglu(xb @ w_gate[e] + b_gate[e], xb @ w_up[e] + b_up[e])
        return h @ w_down[e] + b_down[e]

    y = lax.map(run_block, (rows_tok.reshape(n_blk, ROUTE_BLOCK), blk_expert))
    y = y.reshape(n_rows, D) * rows_gate.astype(xn.dtype)[:, None]
    return jnp.zeros((T + 1, D), xn.dtype).at[rows_tok].add(y)[:T]


def setup_inputs(seed: int = 0) -> dict:
    key = jax.random.key(seed)
    ks = jax.random.split(key, 24)
    f32 = jnp.float32

    def nrm(k, shape, scale):
        return jax.random.normal(k, shape, f32) * scale

    L = DEPTH
    return {
        "x": nrm(ks[0], (BATCH, SEQ, D_MODEL), 1.0),
        "mem": nrm(ks[1], (BATCH, N_MEM, D_MODEL), 1.0),
        "norm_mix_g": 1.0 + nrm(ks[2], (L, D_MODEL), 0.05),
        "norm_mem_g": 1.0 + nrm(ks[3], (L, D_MODEL), 0.05),
        "w_in": nrm(ks[4], (L, D_MODEL, IN_WIDTH), D_MODEL ** -0.5),
        "w_pool_group": nrm(ks[5], (L, N_POOL_GROUPS, POOL_GROUP_DIM, POOL_GROUP_DIM), POOL_GROUP_DIM ** -0.5),
        "pool_scale": 1.0 + nrm(ks[6], (L, POOL_WIDTH), 0.05),
        "w_pool_proj": nrm(ks[7], (L, POOL_WIDTH, D_MODEL), POOL_WIDTH ** -0.5),
        "w_sb_proj": nrm(ks[8], (L, SB_WIDTH, D_MODEL), SB_WIDTH ** -0.5),
        "w_mem_kv": nrm(ks[9], (L, D_MODEL, 2 * XA_WIDTH), D_MODEL ** -0.5),
        "w_mem_proj": nrm(ks[10], (L, XA_WIDTH, D_MODEL), XA_WIDTH ** -0.5),
        "w_out": nrm(ks[11], (L, D_MODEL, D_MODEL), D_MODEL ** -0.5),
        "norm_ffn_g": 1.0 + nrm(ks[12], (L, D_MODEL), 0.05),
        "w_router": nrm(ks[13], (L, D_MODEL, N_EXPERTS), D_MODEL ** -0.5),
        "b_router": nrm(ks[14], (L, N_EXPERTS), 0.01),
        "w_gate": nrm(ks[15], (L, N_EXPERTS, D_MODEL, D_FF), D_MODEL ** -0.5),
        "b_gate": nrm(ks[16], (L, N_EXPERTS, D_FF), 0.01),
        "w_up": nrm(ks[17], (L, N_EXPERTS, D_MODEL, D_FF), D_MODEL ** -0.5),
        "b_up": nrm(ks[18], (L, N_EXPERTS, D_FF), 0.01),
        "w_down": nrm(ks[19], (L, N_EXPERTS, D_FF, D_MODEL), D_FF ** -0.5),
        "b_down": nrm(ks[20], (L, N_EXPERTS, D_MODEL), 0.01),
        "norm_final_g": 1.0 + nrm(ks[21], (D_MODEL,), 0.05),
    }


def reference(x, mem, norm_mix_g, norm_mem_g, w_in, w_pool_group, pool_scale, w_pool_proj,
              w_sb_proj, w_mem_kv, w_mem_proj, w_out, norm_ffn_g, w_router, b_router,
              w_gate, b_gate, w_up, b_up, w_down, b_down, norm_final_g):
    B, S, D = x.shape
    split_at = [int(v) for v in np.cumsum(IN_SPLITS)[:-1]]
    h = x
    for l in range(DEPTH):
        xn = rmsnorm(h, norm_mix_g[l])
        u_pool, q_sb, k_sb, v_sb, q_xa, gate_logits = jnp.split(xn @ w_in[l], split_at, axis=-1)
        y_pool = pool_mixer(u_pool, w_pool_group[l], pool_scale[l]) @ w_pool_proj[l]
        heads = lambda t: t.reshape(B, S, SB_HEADS, SB_HEAD_DIM)
        y_sb = stick_breaking_attention(heads(q_sb), heads(k_sb), heads(v_sb)).reshape(B, S, SB_WIDTH)
        y_sb = y_sb @ w_sb_proj[l]
        mem_n = rmsnorm(mem, norm_mem_g[l])
        y_xa = memory_attention(q_xa, mem_n, w_mem_kv[l]) @ w_mem_proj[l]
        gates = jax.nn.sigmoid(gate_logits.astype(jnp.float32)).astype(h.dtype)
        gates = gates.reshape(B, S, N_BRANCHES, D)
        merged = gates[:, :, 0] * y_pool + gates[:, :, 1] * y_sb + gates[:, :, 2] * y_xa
        h = h + merged @ w_out[l]
        hn = rmsnorm(h, norm_ffn_g[l]).reshape(B * S, D)
        h = h + moe_ffn(hn, w_router[l], b_router[l], w_gate[l], b_gate[l], w_up[l], b_up[l],
                        w_down[l], b_down[l]).reshape(B, S, D)
    return rmsnorm(h, norm_final_g)
```

```cpp
#include <hip/hip_runtime.h>
#include <cstdio>
#include <cstdint>

#ifndef PG8_ALIGN
#define PG8_ALIGN true
#endif
#ifndef MK_N_LAUNCHES
#define MK_N_LAUNCHES 1
#endif

#define LAS __attribute__((address_space(3)))
#define GAS __attribute__((address_space(1)))
typedef unsigned short bf16_t;
typedef short bf16x8 __attribute__((ext_vector_type(8)));
typedef short s16x4 __attribute__((ext_vector_type(4)));
typedef float f32x2 __attribute__((ext_vector_type(2)));
typedef float f32x4 __attribute__((ext_vector_type(4)));
typedef float f32x16 __attribute__((ext_vector_type(16)));
typedef unsigned u32x2 __attribute__((ext_vector_type(2)));
typedef unsigned u32x4 __attribute__((ext_vector_type(4)));

constexpr int T = 16384, DM = 2048, NB = 8, SEQ = 2048, NMEM = 256, INW = 10240, NE = 32, TOPK = 4, CAP = 16384, DFF = 2048;
constexpr int MEMR = NB * NMEM;
constexpr int C_POOL = 0, C_QSB = 512, C_KSB = 1536, C_VSB = 2560, C_QXA = 3584, C_GATE = 4096;
constexpr float EPS = 1e-5f;
constexpr int NROWS_MAX = 73728;

constexpr size_t MiB = 1u << 20;
constexpr size_t WS_CTL = 0, CTL_ZERO_BYTES = 1 * MiB;
constexpr size_t WS_WIN = 1 * MiB;
constexpr size_t WS_WING8 = WS_WIN + (size_t)C_GATE * DM * 2;
constexpr size_t WS_WMIX = WS_WIN + (size_t)INW * DM * 2;
constexpr size_t WS_WKV = WS_WMIX + (size_t)DM * DM * 2;
constexpr size_t WS_WOUT = WS_WKV + (size_t)1024 * DM * 2;
constexpr size_t WS_WG = WS_WOUT + (size_t)DM * DM * 2;
constexpr size_t WS_WU = WS_WG + (size_t)NE * DM * DFF * 2;
constexpr size_t WS_WD = WS_WU + (size_t)NE * DM * DFF * 2;
constexpr size_t WS_P = WS_WD + (size_t)NE * DM * DFF * 2;
constexpr size_t WS_ACT = WS_P;
constexpr size_t WS_XN = WS_P + (size_t)T * INW * 2;
constexpr size_t WS_MEMN = WS_XN + (size_t)T * DM * 2;
constexpr size_t WS_KVXA = WS_MEMN + (size_t)MEMR * DM * 2;
constexpr size_t WS_MIX = WS_KVXA + (size_t)MEMR * 1024 * 2;
constexpr size_t WS_MERGED = WS_MIX + (size_t)T * DM * 2;
constexpr size_t WS_HN = WS_MERGED + (size_t)T * DM * 2;
constexpr size_t WS_ROWSTOK = WS_HN + (size_t)T * DM * 2;
constexpr size_t WS_GATEW = WS_ROWSTOK + (size_t)NE * CAP * 4;
constexpr size_t WS_TOKSLOT = WS_GATEW + (size_t)NE * CAP * 4;
constexpr size_t WS_WRT = WS_TOKSLOT + 512 * 1024;
constexpr size_t WS_XN8 = WS_TOKSLOT + 1 * MiB;
constexpr size_t WS_Y = WS_XN8 + (size_t)T * DM;
constexpr size_t WS_GATE8 = WS_Y + (size_t)NROWS_MAX * DM;
constexpr size_t WS_RSTDW = WS_Y + (size_t)NROWS_MAX * DM * 2;
constexpr size_t WS_END = WS_RSTDW + (size_t)NE * CAP * 4;
static_assert(WS_WING8 + (size_t)(INW - C_GATE) * DM <= WS_WMIX, "fp8 gate weights fit behind the bf16 part");
static_assert(WS_END <= (size_t)2048 * MiB, "workspace map exceeds 2 GiB");
static_assert(WS_GATE8 + (size_t)T * (INW - C_GATE) <= WS_RSTDW, "u8 gate tiles fit behind Y");
static_assert((size_t)NROWS_MAX * DM * 2 <= (size_t)T * INW * 2, "ACT overlays P");
constexpr int CW_BAR = 4096;
constexpr int CW_GCOUNT = 16384;
constexpr int CW_PARTA = 16384 + 64;

constexpr int RING_BYTES = 131072;
constexpr int LDS_TAB = RING_BYTES;
constexpr int LDS_MISC = RING_BYTES + 1024;
constexpr int LDS_EPI = RING_BYTES + 2048;
constexpr int LDS_BYTES = 147456;
constexpr int NWAVES = 8, NTHR = 512;

__device__ __forceinline__ unsigned cvt_pk_bf16(float lo, float hi) { unsigned r; asm volatile("v_cvt_pk_bf16_f32 %0, %1, %2" : "=v"(r) : "v"(lo), "v"(hi)); return r; }
__device__ __forceinline__ float bf_lo(unsigned w) { return __uint_as_float(w << 16); }
__device__ __forceinline__ float bf_hi(unsigned w) { return __uint_as_float(w & 0xffff0000u); }
__device__ __forceinline__ float wave_sum(float v) {
#pragma unroll
    for (int o = 1; o < 64; o <<= 1) v += __shfl_xor(v, o);
    return v;
}
__device__ __forceinline__ float fast_sigmoid(float x) { return __builtin_amdgcn_rcpf(1.0f + __builtin_amdgcn_exp2f(-1.4426950408889634f * x)); }
#define LDS_WAIT() asm volatile("s_waitcnt lgkmcnt(0)" ::: "memory")
#define VM_WAIT() asm volatile("s_waitcnt vmcnt(0)" ::: "memory")

namespace pg8 {
constexpr int BM = 256, BK = 64, HALF = 128, HTB = HALF * BK * 2, STAGE_BYTES = 8 * HTB, NXCD = 8, WGM = 8;
__host__ __device__ __forceinline__ int lds_byte(int r, int c) { return r * 128 + ((((c >> 3) ^ (r >> 1)) & 7) << 4) + (c & 7) * 2; }
__host__ __device__ __forceinline__ void stage_rc(int b, int& R, int& C) { R = b >> 7; const int p = (b >> 4) & 7; C = ((p ^ (R >> 1)) & 7) * 8; }
__host__ __device__ __forceinline__ int perm32(int rho) { const int n = rho >> 4, i = rho & 15; return 8 * (i >> 2) + 4 * n + (i & 3); }

struct Unit { int pm, pn, e, mt, cnt; };
typedef int v4i_t __attribute__((ext_vector_type(4)));
typedef int v8i_t __attribute__((ext_vector_type(8)));
__device__ __forceinline__ bf16x8 lo8(v8i_t v) { return __builtin_bit_cast(bf16x8, (v4i_t)__builtin_shufflevector(v, v, 0, 1, 2, 3)); }
__device__ __forceinline__ bf16x8 hi8(v8i_t v) { return __builtin_bit_cast(bf16x8, (v4i_t)__builtin_shufflevector(v, v, 4, 5, 6, 7)); }
__device__ __forceinline__ v8i_t cat8(bf16x8 a, bf16x8 b) { const v4i_t x = __builtin_bit_cast(v4i_t, a), y = __builtin_bit_cast(v4i_t, b); return __builtin_shufflevector(x, y, 0, 1, 2, 3, 4, 5, 6, 7); }

template <bool FP8_> struct DenseProbT {
    static constexpr bool GATHER = false, FP8 = FP8_;
    const void* A; const void* Bt; int M, N, Kb;
    int nM, nN, nwg, G, c;
    __device__ __forceinline__ void init(const void* A_, const void* Bt_, int M_, int N_, int K_, int G_, int c_) { A = A_; Bt = Bt_; M = M_; N = N_; Kb = FP8_ ? K_ : K_ * 2; nM = M / BM; nN = N / BM; nwg = nM * nN; G = G_; c = c_; }
    __device__ __forceinline__ bool next(int i, Unit& u) const {
        const long L = (long)i * G + c; if (L >= nwg) return false;
        int wgid = (int)L; { const int q = nwg / NXCD, r = nwg % NXCD, xcd = wgid % NXCD, off = wgid / NXCD; wgid = (xcd < r ? xcd * (q + 1) : r * (q + 1) + (xcd - r) * q) + off; }
        const int nig = WGM * nN, gid = wgid / nig, fm = gid * WGM, gsz = (nM - fm) < WGM ? (nM - fm) : WGM;
        u.pm = fm + ((wgid % nig) % gsz); u.pn = (wgid % nig) / gsz; u.e = 0; u.mt = 0; u.cnt = 0; return true;
    }
    __device__ __forceinline__ const char* a_ptr(const Unit& u) const { return (const char*)A + (size_t)u.pm * 256 * Kb; }
    __device__ __forceinline__ const char* a_base() const { return (const char*)A; }
    __device__ __forceinline__ void a_gather(const Unit&, unsigned (&)[2][2]) const {}
    __device__ __forceinline__ const char* b_ptr(const Unit& u, int h) const { return (const char*)Bt + ((size_t)u.pn * 256 + (size_t)h * 128) * Kb; }
};
typedef DenseProbT<false> DenseProb;
typedef DenseProbT<true> DenseProb8;

template <int NPN  , bool GATHER_>
struct MoeProb {
    static constexpr bool GATHER = GATHER_, FP8 = true;
    const unsigned char* A; const unsigned char* B0; const unsigned char* B1; const int* rows_tok; int Kb; int G, c, total; const LAS int* tab; int uoff;
    __device__ __forceinline__ bool next(int i, Unit& u) const {
        const int L = i * G + c; if (L >= total) return false;
        const int lane = threadIdx.x & 63;
        const int te = (lane < NE) ? tab[uoff + lane] : 0x7fffffff;
        const unsigned long long mk = __ballot(L >= te);
        const int e = __builtin_amdgcn_readfirstlane(__popcll(mk));
        const int start = __builtin_amdgcn_readfirstlane(e ? tab[uoff + e - 1] : 0), ntm = __builtin_amdgcn_readfirstlane(tab[32 + e]);
        const int rem = L - start, per_ng = ntm * 4, ng = rem / per_ng, r2 = rem - ng * per_ng, mt = r2 >> 2, nn = r2 & 3;
        u.e = e; u.mt = mt; u.pn = ng * 4 + nn; u.pm = __builtin_amdgcn_readfirstlane(tab[64 + e]) + mt; u.cnt = __builtin_amdgcn_readfirstlane(tab[96 + e]); return true;
    }
    __device__ __forceinline__ const char* a_ptr(const Unit& u) const { return (const char*)A + (size_t)u.pm * 256 * Kb; }
    __device__ __forceinline__ const char* a_base() const { return (const char*)A; }
    __device__ __forceinline__ void a_gather(const Unit& u, unsigned (&off)[2][2]) const {
#pragma unroll
        for (int i = 0; i < 2; ++i) { int R, C; stage_rc((int)threadIdx.x * 16 + i * 8192, R, C);
#pragma unroll
            for (int h = 0; h < 2; ++h) { const int lr = u.mt * 256 + h * 128 + R; int tok = rows_tok[u.e * CAP + lr]; tok = (lr < u.cnt) ? tok : 0; off[h][i] = (unsigned)tok * (unsigned)Kb + (unsigned)(C * 2); } }
    }
    __device__ __forceinline__ void a_gather_lds(const Unit& u, unsigned (&off)[2][2], const LAS int* ids) const {
#pragma unroll
        for (int i = 0; i < 2; ++i) { int R, C; stage_rc((int)threadIdx.x * 16 + i * 8192, R, C);
#pragma unroll
            for (int h = 0; h < 2; ++h) { const int lr = u.mt * 256 + h * 128 + R; int tok = ids[h * 128 + R]; tok = (lr < u.cnt) ? tok : 0; off[h][i] = (unsigned)tok * (unsigned)Kb + (unsigned)(C * 2); } }
    }
    __device__ __forceinline__ void gather_dma(const Unit& u, unsigned lds_dst) const;
    __device__ __forceinline__ const char* b_ptr(const Unit& u, int h) const {
        if (NPN == 16) return (const char*)(h ? B1 : B0) + ((size_t)u.e * DFF + (size_t)u.pn * 128) * Kb;
        return (const char*)B0 + ((size_t)u.e * DM + (size_t)u.pn * 256 + (size_t)h * 128) * Kb;
    }
};

__device__ __forceinline__ void glds16(const char* base, unsigned voff, unsigned lds_dst) {
    asm volatile("s_mov_b32 m0, %2\n\ts_nop 0\n\tglobal_load_lds_dwordx4 %0, %1" :: "v"(voff), "s"(base), "s"(lds_dst) : "memory");
}
template <int NPN, bool GATHER_>
__device__ __forceinline__ void MoeProb<NPN, GATHER_>::gather_dma(const Unit& u, unsigned lds_dst) const {
    glds16((const char*)(rows_tok + (size_t)u.e * CAP + (size_t)u.mt * 256), (unsigned)(threadIdx.x & 63) * 16u, lds_dst);
}
constexpr int GX_OFF = 128 * 1024 + 4096;
template <class Prob, class Epi, bool ALIGN_EPI = PG8_ALIGN>
__device__ __forceinline__ void gemm_phase(LAS unsigned char* lds, const Prob& P, const Epi& E) {
    constexpr bool GATHER = Prob::GATHER;
    const int tid = threadIdx.x, wid = __builtin_amdgcn_readfirstlane(tid >> 6), lane = tid & 63, wr = wid >> 2, wc = wid & 3, fr = lane & 15, fq = lane >> 4;
    constexpr bool FP8 = Prob::FP8;
    const int Kb = P.Kb, nt = Kb / (BK * 2);
    unsigned voffA[2], voffB[2];
#pragma unroll
    for (int i = 0; i < 2; ++i) { int R, C; stage_rc(tid * 16 + i * 8192, R, C); const int Rb = Epi::PERM ? ((R & ~31) + perm32(R & 31)) : R;
        voffA[i] = (unsigned)(R * Kb + C * 2); voffB[i] = (unsigned)(Rb * Kb + C * 2); }
    const size_t kstep = (size_t)(BK * 2);
    const size_t hstep = (size_t)HALF * Kb;
    const unsigned ldsw = (unsigned)wid * 1024u;
    const unsigned lds_u = (unsigned)(size_t)lds;
    const int aoff = lds_byte(wr * 64 + fr, fq * 8), boff = lds_byte(wc * 32 + fr, fq * 8);
    const int aoff1 = aoff ^ 64, boff1 = boff ^ 64;
#define PG8_SA(b, h) (((b) * 2 + (h)) * HTB)
#define PG8_SB(b, h) ((4 + (b) * 2 + (h)) * HTB)
#define PG8_STAGE2(bufoff, p, o0, o1) do { glds16((const char*)(p), (o0), lds_u + (unsigned)(bufoff) + ldsw); glds16((const char*)(p), (o1), lds_u + (unsigned)(bufoff) + ldsw + 8192u); } while (0)
#define PG8_STAGE_A(bufoff, h, nx, tt) do { if constexpr (GATHER) { const char* p_ = Ab + (size_t)(tt) * kstep; PG8_STAGE2(bufoff, p_, ((nx) ? noff[h][0] : coff[h][0]), ((nx) ? noff[h][1] : coff[h][1])); } \
        else { const char* p_ = ((nx) ? nA : cA) + (size_t)(h) * hstep + (size_t)(tt) * kstep; PG8_STAGE2(bufoff, p_, voffA[0], voffA[1]); } } while (0)
#define PG8_STAGE_B(bufoff, h, nx, tt) do { const char* p_ = ((nx) ? nB[h] : cB[h]) + (size_t)(tt) * kstep; PG8_STAGE2(bufoff, p_, voffB[0], voffB[1]); } while (0)
#define PG8_LDA(dst, b, h) do { _Pragma("unroll") for (int m = 0; m < 4; ++m) dst[m] = cat8(*(const LAS bf16x8*)(lds + PG8_SA(b, h) + aoff + m * 2048), *(const LAS bf16x8*)(lds + PG8_SA(b, h) + aoff1 + m * 2048)); } while (0)
#define PG8_LDB(dst, b, h) do { _Pragma("unroll") for (int n = 0; n < 2; ++n) dst[n] = cat8(*(const LAS bf16x8*)(lds + PG8_SB(b, h) + boff + n * 2048), *(const LAS bf16x8*)(lds + PG8_SB(b, h) + boff1 + n * 2048)); } while (0)
#define PG8_MMA(ai, bj, At, Bt) do { __builtin_amdgcn_s_setprio(1); _Pragma("unroll") for (int m = 0; m < 4; ++m) _Pragma("unroll") for (int n = 0; n < 2; ++n) { \
        if constexpr (FP8) asm volatile("v_mfma_scale_f32_16x16x128_f8f6f4 %0, %1, %2, %0, %3, %3 op_sel_hi:[0,0,0]" : "+v"(acc[ai][bj][m][n]) : "v"(Bt[n]), "v"(At[m]), "v"(fp8_one)); \
        else { acc[ai][bj][m][n] = __builtin_amdgcn_mfma_f32_16x16x32_bf16(lo8(Bt[n]), lo8(At[m]), acc[ai][bj][m][n], 0, 0, 0); \
               acc[ai][bj][m][n] = __builtin_amdgcn_mfma_f32_16x16x32_bf16(hi8(Bt[n]), hi8(At[m]), acc[ai][bj][m][n], 0, 0, 0); } } \
        __builtin_amdgcn_s_setprio(0); } while (0)
#define PG8_WAIT_V(n) asm volatile("s_waitcnt vmcnt(" #n ")" ::: "memory")
#define PG8_WAIT_L(n) asm volatile("s_waitcnt lgkmcnt(" #n ")" ::: "memory")
#define PG8_BAR __builtin_amdgcn_s_barrier()
#define PG8_SCHED __builtin_amdgcn_sched_barrier(0)
    Unit cur, nxt; int ui = 0;
    if (!P.next(0, cur)) return;
    f32x4 acc[2][2][4][2];
#pragma unroll
    for (int a = 0; a < 2; ++a)
#pragma unroll
        for (int b = 0; b < 2; ++b)
#pragma unroll
            for (int m = 0; m < 4; ++m)
#pragma unroll
                for (int n = 0; n < 2; ++n) acc[a][b][m][n] = (f32x4){0.f, 0.f, 0.f, 0.f};
    v8i_t At[4], B0[2], B1[2];
    const int fp8_one = 0x7f7f7f7f;
    const char* Ab = P.a_base();
    const char* cA = nullptr; const char* nA = nullptr; const char* cB[2]; const char* nB[2];
    unsigned coff[2][2] = {{0u, 0u}, {0u, 0u}}, noff[2][2] = {{0u, 0u}, {0u, 0u}};
    if constexpr (GATHER) P.a_gather(cur, coff); else cA = P.a_ptr(cur);
    cB[0] = P.b_ptr(cur, 0); cB[1] = P.b_ptr(cur, 1);
    PG8_STAGE_B(PG8_SB(0, 0), 0, false, 0); PG8_STAGE_B(PG8_SB(0, 1), 1, false, 0); PG8_STAGE_A(PG8_SA(0, 0), 0, false, 0); PG8_STAGE_A(PG8_SA(0, 1), 1, false, 0);
    if (wr == 1) PG8_BAR;
    PG8_WAIT_V(2); PG8_BAR;
    PG8_STAGE_B(PG8_SB(1, 0), 0, false, 1); PG8_STAGE_B(PG8_SB(1, 1), 1, false, 1);
    PG8_WAIT_V(6); PG8_BAR;
    for (;;) {
        const bool has_next = P.next(ui + 1, nxt);
        if constexpr (GATHER) {
            Unit nx2; const bool has_nx2 = has_next && P.next(ui + 2, nx2);
            if (has_nx2 && wid == 0) P.gather_dma(nx2, lds_u + (unsigned)GX_OFF + (unsigned)(ui & 1) * 1024u);
            if (has_next) { if (ui == 0) P.a_gather(nxt, noff); else P.a_gather_lds(nxt, noff, (const LAS int*)(lds + GX_OFF + ((ui + 1) & 1) * 1024)); }
        }
        if (has_next) { if constexpr (!GATHER) nA = P.a_ptr(nxt); nB[0] = P.b_ptr(nxt, 0); nB[1] = P.b_ptr(nxt, 1); }
        else { if constexpr (GATHER) { noff[0][0] = coff[0][0]; noff[0][1] = coff[0][1]; noff[1][0] = coff[1][0]; noff[1][1] = coff[1][1]; } else nA = cA; nB[0] = cB[0]; nB[1] = cB[1]; }
        for (int t = 0; t < nt; t += 2) {
            if constexpr (Epi::HAS_MID) { if (t == Epi::T1 || t == Epi::T2) E.mid(acc, cur, t, wr, wc, fr, fq); }
            const bool last = (t == nt - 2);
            if constexpr (Epi::HAS_PRE) { if (last) E.pre(cur, wid, lane); }
            const int t2 = last ? 0 : t + 2, t3 = t2 + 1;
            PG8_LDB(B0, 0, 0); PG8_LDB(B1, 0, 1); PG8_SCHED; PG8_LDA(At, 0, 0); PG8_STAGE_A(PG8_SA(1, 0), 0, false, t + 1); PG8_STAGE_A(PG8_SA(1, 1), 1, false, t + 1);
            PG8_WAIT_V(8); PG8_WAIT_L(0); PG8_BAR; PG8_MMA(0, 0, At, B0); PG8_MMA(0, 1, At, B1); PG8_BAR; PG8_SCHED;
            PG8_LDA(At, 0, 1); PG8_STAGE_B(PG8_SB(0, 0), 0, last, t2); PG8_STAGE_B(PG8_SB(0, 1), 1, last, t2);
            PG8_WAIT_V(6); PG8_WAIT_L(0); PG8_BAR; PG8_MMA(1, 0, At, B0); PG8_MMA(1, 1, At, B1); PG8_BAR; PG8_SCHED;
            PG8_LDB(B0, 1, 0); PG8_LDB(B1, 1, 1); PG8_SCHED; PG8_LDA(At, 1, 0); PG8_STAGE_A(PG8_SA(0, 0), 0, last, t2); PG8_STAGE_A(PG8_SA(0, 1), 1, last, t2);
            PG8_WAIT_V(8); PG8_WAIT_L(0); PG8_BAR; PG8_MMA(0, 0, At, B0); PG8_MMA(0, 1, At, B1); PG8_BAR; PG8_SCHED;
            PG8_LDA(At, 1, 1); PG8_STAGE_B(PG8_SB(1, 0), 0, last, t3); PG8_STAGE_B(PG8_SB(1, 1), 1, last, t3);
            PG8_WAIT_V(6); PG8_WAIT_L(0); PG8_BAR; PG8_MMA(1, 0, At, B0); PG8_MMA(1, 1, At, B1); PG8_BAR; PG8_SCHED;
        }
        if constexpr (ALIGN_EPI) { if (wr == 0) PG8_BAR; }
        if constexpr (FP8) asm volatile("s_nop 15\n\ts_nop 15" ::: "memory");
        E(acc, cur, wr, wc, fr, fq);
        if (!has_next) break;
#pragma unroll
        for (int a = 0; a < 2; ++a)
#pragma unroll
            for (int b = 0; b < 2; ++b)
#pragma unroll
                for (int m = 0; m < 4; ++m)
#pragma unroll
                    for (int n = 0; n < 2; ++n) acc[a][b][m][n] = (f32x4){0.f, 0.f, 0.f, 0.f};
        cur = nxt; cB[0] = nB[0]; cB[1] = nB[1]; ++ui;
        if constexpr (GATHER) { coff[0][0] = noff[0][0]; coff[0][1] = noff[0][1]; coff[1][0] = noff[1][0]; coff[1][1] = noff[1][1]; } else cA = nA;
        if constexpr (ALIGN_EPI) { if (wr == 1) PG8_BAR; }
    }
    PG8_WAIT_V(0);
    if constexpr (!ALIGN_EPI) { if (wr == 0) PG8_BAR; }
    PG8_BAR;
#undef PG8_SA
#undef PG8_SB
#undef PG8_STAGE2
#undef PG8_STAGE_A
#undef PG8_STAGE_B
#undef PG8_LDA
#undef PG8_LDB
#undef PG8_MMA
#undef PG8_WAIT_V
#undef PG8_WAIT_L
#undef PG8_BAR
#undef PG8_SCHED
}

struct EpiStoreBf16 {
    static constexpr bool PERM = true, HAS_MID = false, HAS_PRE = false;
    bf16_t* O; int ldc; int sig_from; float scale;
    __device__ __forceinline__ void operator()(const f32x4 (&acc)[2][2][4][2], const Unit& u, int wr, int wc, int fr, int fq) const {
        const int row0 = u.pm * BM + wr * 64 + fr, col0 = u.pn * BM + wc * 32 + 8 * fq;
        const bool sg = u.pn >= sig_from;
#pragma unroll
        for (int ai = 0; ai < 2; ++ai)
#pragma unroll
            for (int m = 0; m < 4; ++m) { bf16_t* rowp = O + (size_t)(row0 + ai * HALF + m * 16) * ldc + col0;
#pragma unroll
                for (int bj = 0; bj < 2; ++bj) { f32x4 v0 = acc[ai][bj][m][0] * scale, v1 = acc[ai][bj][m][1] * scale;
                    if (sg) {
#pragma unroll
                        for (int j = 0; j < 4; ++j) { v0[j] = fast_sigmoid(v0[j]); v1[j] = fast_sigmoid(v1[j]); } }
                    u32x4 w; w.x = cvt_pk_bf16(v0[0], v0[1]); w.y = cvt_pk_bf16(v0[2], v0[3]); w.z = cvt_pk_bf16(v1[0], v1[1]); w.w = cvt_pk_bf16(v1[2], v1[3]);
                    *(u32x4*)(rowp + bj * HALF) = w; } }
    }
};
__device__ __forceinline__ unsigned pk4_u8(f32x4 v) { unsigned w = 0;
    w = __builtin_amdgcn_cvt_pk_u8_f32(v[0], 0, w); w = __builtin_amdgcn_cvt_pk_u8_f32(v[1], 1, w); w = __builtin_amdgcn_cvt_pk_u8_f32(v[2], 2, w); w = __builtin_amdgcn_cvt_pk_u8_f32(v[3], 3, w); return w; }
constexpr int GATE_TILES_N = (INW - C_GATE) / BM;
__device__ __forceinline__ size_t gate_tile_off(int pm, int tn, int wr, int wc, int fr, int fq) { return ((size_t)(pm * GATE_TILES_N + tn) << 16) + (size_t)(((wr * 4 + wc) * 64 + fq * 16 + fr) * 8); }
struct EpiGateU8 {
    static constexpr bool PERM = true, HAS_MID = false, HAS_PRE = false;
    unsigned char* O; float scale;
    __device__ __forceinline__ void operator()(const f32x4 (&acc)[2][2][4][2], const Unit& u, int wr, int wc, int fr, int fq) const {
        unsigned char* base = O + gate_tile_off(u.pm, u.pn, wr, wc, fr, fq);
#pragma unroll
        for (int ai = 0; ai < 2; ++ai)
#pragma unroll
            for (int m = 0; m < 4; ++m)
#pragma unroll
                for (int bj = 0; bj < 2; ++bj) { f32x4 v0 = acc[ai][bj][m][0] * scale, v1 = acc[ai][bj][m][1] * scale;
#pragma unroll
                    for (int j = 0; j < 4; ++j) { v0[j] = fmaxf(__builtin_rintf(255.0f * fast_sigmoid(v0[j])), 1.0f); v1[j] = fmaxf(__builtin_rintf(255.0f * fast_sigmoid(v1[j])), 1.0f); }
                    u32x2 w; w.x = pk4_u8(v0); w.y = pk4_u8(v1);
                    *(u32x2*)(base + ((ai * 4 + m) * 2 + bj) * 4096) = w; }
    }
};
struct EpiMix {
    static constexpr bool PERM = true, HAS_MID = true, HAS_PRE = false; static constexpr int T1 = 8, T2 = 24;
    bf16_t* Mg; const unsigned char* G8;
    static __device__ __forceinline__ float ub(unsigned w, int j) { return (float)((w >> (8 * j)) & 0xffu); }
    __device__ __forceinline__ void mid(f32x4 (&acc)[2][2][4][2], const Unit& u, int t, int wr, int wc, int fr, int fq) const {
        const int gi = (t == T1) ? 0 : 1;
        const unsigned char* pa = G8 + gate_tile_off(u.pm, gi * 8 + u.pn, wr, wc, fr, fq); const unsigned char* pb = pa + ((size_t)8 << 16);
#pragma unroll
        for (int ai = 0; ai < 2; ++ai) {
            u32x2 ga[4][2], gb[4][2];
#pragma unroll
            for (int m = 0; m < 4; ++m)
#pragma unroll
                for (int bj = 0; bj < 2; ++bj) { ga[m][bj] = *(const u32x2*)(pa + ((ai * 4 + m) * 2 + bj) * 4096); gb[m][bj] = *(const u32x2*)(pb + ((ai * 4 + m) * 2 + bj) * 4096); }
#pragma unroll
            for (int m = 0; m < 4; ++m)
#pragma unroll
                for (int bj = 0; bj < 2; ++bj) { const u32x2 a = ga[m][bj], b = gb[m][bj]; f32x4& v0 = acc[ai][bj][m][0]; f32x4& v1 = acc[ai][bj][m][1];
#pragma unroll
                    for (int j = 0; j < 4; ++j) { v0[j] *= ub(a.x, j) * __builtin_amdgcn_rcpf(ub(b.x, j)); v1[j] *= ub(a.y, j) * __builtin_amdgcn_rcpf(ub(b.y, j)); } }
            asm volatile("" ::: "memory"); }
    }
    __device__ __forceinline__ void operator()(const f32x4 (&acc)[2][2][4][2], const Unit& u, int wr, int wc, int fr, int fq) const {
        const int row0 = u.pm * BM + wr * 64 + fr, col0 = u.pn * BM + wc * 32 + 8 * fq;
        const unsigned char* pg = G8 + gate_tile_off(u.pm, 16 + u.pn, wr, wc, fr, fq);
        constexpr float IQ = 1.0f / 255.0f;
#pragma unroll
        for (int ai = 0; ai < 2; ++ai) {
            u32x2 gq[4][2];
#pragma unroll
            for (int m = 0; m < 4; ++m)
#pragma unroll
                for (int bj = 0; bj < 2; ++bj) gq[m][bj] = *(const u32x2*)(pg + ((ai * 4 + m) * 2 + bj) * 4096);
#pragma unroll
            for (int m = 0; m < 4; ++m) { const size_t row = (size_t)(row0 + ai * HALF + m * 16);
#pragma unroll
                for (int bj = 0; bj < 2; ++bj) { const u32x2 gg = gq[m][bj]; f32x4 v0 = acc[ai][bj][m][0], v1 = acc[ai][bj][m][1];
#pragma unroll
                    for (int j = 0; j < 4; ++j) { v0[j] *= ub(gg.x, j) * IQ; v1[j] *= ub(gg.y, j) * IQ; }
                    u32x4 w; w.x = cvt_pk_bf16(v0[0], v0[1]); w.y = cvt_pk_bf16(v0[2], v0[3]); w.z = cvt_pk_bf16(v1[0], v1[1]); w.w = cvt_pk_bf16(v1[2], v1[3]);
                    *(u32x4*)(Mg + row * DM + col0 + bj * HALF) = w; } }
            asm volatile("" ::: "memory"); }
    }
};
constexpr float W_SCALE = 64.f, ACT_SCALE = 4.f;
__device__ __forceinline__ float clamp_fp8(float x) { return __builtin_amdgcn_fmed3f(x, -448.0f, 448.0f); }
__device__ __forceinline__ unsigned pk4_fp8(float a, float b, float c, float d) { int w = 0; w = __builtin_amdgcn_cvt_pk_fp8_f32(clamp_fp8(a), clamp_fp8(b), w, false); w = __builtin_amdgcn_cvt_pk_fp8_f32(clamp_fp8(c), clamp_fp8(d), w, true); return (unsigned)w; }
struct EpiResid8 {
    static constexpr bool PERM = true, HAS_MID = false, HAS_PRE = false;
    const float* X; bf16_t* Hb; unsigned char* H8;
    __device__ __forceinline__ void operator()(const f32x4 (&acc)[2][2][4][2], const Unit& u, int wr, int wc, int fr, int fq) const {
        const int row0 = u.pm * BM + wr * 64 + fr, col0 = u.pn * BM + wc * 32 + 8 * fq;
#pragma unroll
        for (int ai = 0; ai < 2; ++ai) {
            f32x4 xq[4][2][2];
#pragma unroll
            for (int m = 0; m < 4; ++m) { const size_t off = (size_t)(row0 + ai * HALF + m * 16) * DM + col0;
#pragma unroll
                for (int bj = 0; bj < 2; ++bj) { xq[m][bj][0] = *(const f32x4*)(X + off + bj * HALF); xq[m][bj][1] = *(const f32x4*)(X + off + bj * HALF + 4); } }
#pragma unroll
            for (int m = 0; m < 4; ++m) { const size_t off = (size_t)(row0 + ai * HALF + m * 16) * DM + col0;
#pragma unroll
                for (int bj = 0; bj < 2; ++bj) { const f32x4 v0 = xq[m][bj][0] + acc[ai][bj][m][0], v1 = xq[m][bj][1] + acc[ai][bj][m][1];
                    u32x4 w; w.x = cvt_pk_bf16(v0[0], v0[1]); w.y = cvt_pk_bf16(v0[2], v0[3]); w.z = cvt_pk_bf16(v1[0], v1[1]); w.w = cvt_pk_bf16(v1[2], v1[3]);
                    *(u32x4*)(Hb + off + bj * HALF) = w;
                    u32x2 q; q.x = pk4_fp8(bf_lo(w.x), bf_hi(w.x), bf_lo(w.y), bf_hi(w.y)); q.y = pk4_fp8(bf_lo(w.z), bf_hi(w.z), bf_lo(w.w), bf_hi(w.w));
                    *(u32x2*)(H8 + off + bj * HALF) = q; } }
            asm volatile("" ::: "memory"); }
    }
};
struct EpiSwiglu {
    static constexpr bool PERM = true, HAS_MID = false, HAS_PRE = true;
    unsigned char* Act; const float* bg; const float* bu; const float* rstdw; LAS unsigned char* le;
    __device__ __forceinline__ void pre(const Unit& u, int wid, int lane) const {
        const unsigned dst = (unsigned)(size_t)le;
        if (wid == 0) glds16((const char*)(rstdw + (size_t)u.e * CAP + (size_t)u.mt * BM), (unsigned)lane * 16u, dst);
        else if (wid == 1) { if (lane < 32) glds16((const char*)(bg + (size_t)u.e * DFF + (size_t)u.pn * HALF), (unsigned)lane * 16u, dst + 1024u);
                             else glds16((const char*)(bu + (size_t)u.e * DFF + (size_t)u.pn * HALF), (unsigned)(lane - 32) * 16u, dst + 1024u); }
    }
    __device__ __forceinline__ void operator()(const f32x4 (&acc)[2][2][4][2], const Unit& u, int wr, int wc, int fr, int fq) const {
        const int row0 = u.pm * BM + wr * 64 + fr, col0 = u.pn * HALF + wc * 32 + 8 * fq;
        const LAS float* rsl = (const LAS float*)le + wr * 64 + fr; const LAS unsigned char* bl = le + 1024 + (wc * 32 + 8 * fq) * 4;
        const f32x4 g0 = *(const LAS f32x4*)bl, g1 = *(const LAS f32x4*)(bl + 16), u0 = *(const LAS f32x4*)(bl + 512), u1 = *(const LAS f32x4*)(bl + 528);
        constexpr float IW = 1.0f / W_SCALE;
#pragma unroll
        for (int ai = 0; ai < 2; ++ai)
#pragma unroll
            for (int m = 0; m < 4; ++m) { unsigned char* rowp = Act + (size_t)(row0 + ai * HALF + m * 16) * DFF + col0;
                const float rs = IW * rsl[ai * HALF + m * 16];
                f32x4 a0 = acc[ai][0][m][0] * rs + g0, a1 = acc[ai][0][m][1] * rs + g1, b0 = acc[ai][1][m][0] * rs + u0, b1 = acc[ai][1][m][1] * rs + u1, r0, r1;
#pragma unroll
                for (int j = 0; j < 4; ++j) {
                    float g = fminf(a0[j], 7.0f), up = fminf(fmaxf(b0[j], -7.0f), 7.0f); r0[j] = ACT_SCALE * g * fast_sigmoid(1.702f * g) * (up + 1.0f);
                    g = fminf(a1[j], 7.0f); up = fminf(fmaxf(b1[j], -7.0f), 7.0f); r1[j] = ACT_SCALE * g * fast_sigmoid(1.702f * g) * (up + 1.0f); }
                u32x2 w; w.x = pk4_fp8(r0[0], r0[1], r0[2], r0[3]); w.y = pk4_fp8(r1[0], r1[1], r1[2], r1[3]);
                *(u32x2*)rowp = w; }
    }
};
constexpr float Y_SCALE = 16.f;
struct EpiDown {
    static constexpr bool PERM = true, HAS_MID = false, HAS_PRE = true;
    unsigned char* Y; const float* bd; const float* gatew; LAS unsigned char* le;
    __device__ __forceinline__ void pre(const Unit& u, int wid, int lane) const {
        const unsigned dst = (unsigned)(size_t)le;
        if (wid == 0) glds16((const char*)(gatew + (size_t)u.e * CAP + (size_t)u.mt * BM), (unsigned)lane * 16u, dst);
        else if (wid == 1) glds16((const char*)(bd + (size_t)u.e * DM + (size_t)u.pn * BM), (unsigned)lane * 16u, dst + 1024u);
    }
    __device__ __forceinline__ void operator()(const f32x4 (&acc)[2][2][4][2], const Unit& u, int wr, int wc, int fr, int fq) const {
        const int row0 = u.pm * BM + wr * 64 + fr, col0 = u.pn * BM + wc * 32 + 8 * fq;
        const LAS float* gwl = (const LAS float*)le + wr * 64 + fr; const LAS unsigned char* bl = le + 1024 + (wc * 32 + 8 * fq) * 4;
        constexpr float IS = 1.0f / (W_SCALE * ACT_SCALE);
        f32x4 bv[2][2];
#pragma unroll
        for (int bj = 0; bj < 2; ++bj)
#pragma unroll
            for (int n = 0; n < 2; ++n) bv[bj][n] = *(const LAS f32x4*)(bl + (bj * HALF + 4 * n) * 4);
#pragma unroll
        for (int ai = 0; ai < 2; ++ai)
#pragma unroll
            for (int m = 0; m < 4; ++m) { const float gw = Y_SCALE * gwl[ai * HALF + m * 16];
                unsigned char* rowp = Y + (size_t)(row0 + ai * HALF + m * 16) * DM + col0;
#pragma unroll
                for (int bj = 0; bj < 2; ++bj) { const f32x4 v0 = (acc[ai][bj][m][0] * IS + bv[bj][0]) * gw, v1 = (acc[ai][bj][m][1] * IS + bv[bj][1]) * gw;
                    u32x2 w; w.x = pk4_fp8(v0[0], v0[1], v0[2], v0[3]); w.y = pk4_fp8(v1[0], v1[1], v1[2], v1[3]);
                    *(u32x2*)(rowp + bj * HALF) = w; } }
    }
};
}

namespace att {
constexpr int D = 128, NW = 8, QBLK = 32, KVBLK = 64;
constexpr float SCALE = 0.088388347648318440f;
constexpr float THR = 8.f;
constexpr size_t SHM_V = KVBLK * D * 2, SHM_K = KVBLK * D * 2, SHM_ATTN = 2 * SHM_V + 2 * SHM_K + NW * 64 * 4;
#define KSWZ(row, colB) ((row) * 256 + ((colB) ^ (((row) & 7) << 4)))
#define SBAR() __builtin_amdgcn_sched_barrier(0)
__device__ __forceinline__ int crow(int r, int hi) { return (r & 3) + 8 * (r >> 2) + 4 * hi; }
__device__ __forceinline__ unsigned cvtpk(float lo, float hi) { unsigned r; asm volatile("v_cvt_pk_bf16_f32 %0, %1, %2" : "=v"(r) : "v"(lo), "v"(hi)); return r; }

__device__ __forceinline__ void partialSM(f32x16& p0, f32x16& p1, float& m_reg, float& mn, float& alpha) {
  constexpr float C = SCALE * 1.4426950408889634f;
  float pmax = p0[0]; for (int r = 1; r < 16; ++r) pmax = fmaxf(pmax, p0[r]); for (int r = 0; r < 16; ++r) pmax = fmaxf(pmax, p1[r]);
  { auto rr = __builtin_amdgcn_permlane32_swap(__float_as_uint(pmax), __float_as_uint(pmax), false, false);
    pmax = fmaxf(__uint_as_float(rr[0]), __uint_as_float(rr[1])); }
  if (__builtin_expect(__all(pmax - m_reg <= THR / SCALE), 1)) { mn = m_reg; alpha = 1.f; }
  else { mn = fmaxf(m_reg, pmax); alpha = __builtin_amdgcn_exp2f((m_reg - mn) * C); m_reg = mn; }
  float mnC = -mn * C;
  for (int r = 0; r < 16; ++r) p0[r] = fmaf(p0[r], C, mnC); for (int r = 0; r < 16; ++r) p1[r] = fmaf(p1[r], C, mnC);
  for (int r = 0; r < 16; ++r) p0[r] = __builtin_amdgcn_exp2f(p0[r]);
}
#define PK4(P, BASE, OUT) do { unsigned a0 = cvtpk(P[BASE + 0], P[BASE + 1]), a1 = cvtpk(P[BASE + 2], P[BASE + 3]);   \
    unsigned b0 = cvtpk(P[BASE + 4], P[BASE + 5]), b1 = cvtpk(P[BASE + 6], P[BASE + 7]);                              \
    auto r0 = __builtin_amdgcn_permlane32_swap(a0, b0, false, false); auto r1 = __builtin_amdgcn_permlane32_swap(a1, b1, false, false); \
    u32x4 w = {r0[0], r1[0], r0[1], r1[1]}; OUT = *reinterpret_cast<bf16x8*>(&w); } while (0)
__device__ __forceinline__ void finishSM(f32x16& p0, f32x16& p1, float alpha, float& l_reg, bf16x8& pa0, bf16x8& pa1, bf16x8& pa2, bf16x8& pa3) {
  for (int r = 0; r < 16; ++r) p1[r] = __builtin_amdgcn_exp2f(p1[r]);
  float ps = 0; for (int r = 0; r < 16; ++r) ps += p0[r]; for (int r = 0; r < 16; ++r) ps += p1[r];
  { auto rr = __builtin_amdgcn_permlane32_swap(__float_as_uint(ps), __float_as_uint(ps), false, false);
    ps = __uint_as_float(rr[0]) + __uint_as_float(rr[1]); }
  l_reg = l_reg * alpha + ps;
  PK4(p0, 0, pa0); PK4(p0, 8, pa1); PK4(p1, 0, pa2); PK4(p1, 8, pa3);
}
__device__ __forceinline__ void qkt(f32x16& p0, f32x16& p1, const char* Ks, const bf16x8* qr, int r32, int hi) {
  p0 = f32x16{}; p1 = f32x16{};
#pragma unroll
  for (int d0 = 0; d0 < 8; ++d0) { int cb = (d0 * 16 + hi * 8) * 2;
    bf16x8 b0 = *reinterpret_cast<const bf16x8*>(Ks + KSWZ(r32, cb));
    bf16x8 b1 = *reinterpret_cast<const bf16x8*>(Ks + KSWZ(32 + r32, cb));
    p0 = __builtin_amdgcn_mfma_f32_32x32x16_bf16(b0, qr[d0], p0, 0, 0, 0);
    p1 = __builtin_amdgcn_mfma_f32_32x32x16_bf16(b1, qr[d0], p1, 0, 0, 0); }
}
__device__ __forceinline__ int v_st(int k, int c) { const int kk = (k & ~0xC) | ((k & 4) << 1) | ((k & 8) >> 1); return ((kk >> 3) * 4 + (c >> 5)) * 512 + ((kk & 7) * 32 + (c & 31)) * 2; }
__device__ __forceinline__ int v_rd_base(int lane) { return ((lane & 3) << 3) | (((lane >> 2) & 3) << 6) | (((lane >> 4) & 1) << 5) | (((lane >> 5) & 1) << 8); }
constexpr int v_rd_off(int d0, int ks, int half) { return d0 * 512 + ks * 4096 + half * 2048; }
template <int OFF> __device__ __forceinline__ s16x4 tr_read(int vb) {
  s16x4 r; asm volatile("ds_read_b64_tr_b16 %0, %1 offset:%2" : "=&v"(r) : "v"(vb), "i"(OFF) : "memory"); return r;
}
template <int D0> __device__ __forceinline__ void pv_one(f32x16& od, int vb, bf16x8 pa0, bf16x8 pa1, bf16x8 pa2, bf16x8 pa3) {
  const s16x4 l0 = tr_read<v_rd_off(D0, 0, 0)>(vb), h0 = tr_read<v_rd_off(D0, 0, 1)>(vb), l1 = tr_read<v_rd_off(D0, 1, 0)>(vb), h1 = tr_read<v_rd_off(D0, 1, 1)>(vb);
  const s16x4 l2 = tr_read<v_rd_off(D0, 2, 0)>(vb), h2 = tr_read<v_rd_off(D0, 2, 1)>(vb), l3 = tr_read<v_rd_off(D0, 3, 0)>(vb), h3 = tr_read<v_rd_off(D0, 3, 1)>(vb);
  asm volatile("s_waitcnt lgkmcnt(0)" ::: "memory"); SBAR();
#define PKV(L, H) (bf16x8){L[0], L[1], L[2], L[3], H[0], H[1], H[2], H[3]}
  od = __builtin_amdgcn_mfma_f32_32x32x16_bf16(pa0, PKV(l0, h0), od, 0, 0, 0);
  od = __builtin_amdgcn_mfma_f32_32x32x16_bf16(pa1, PKV(l1, h1), od, 0, 0, 0);
  od = __builtin_amdgcn_mfma_f32_32x32x16_bf16(pa2, PKV(l2, h2), od, 0, 0, 0);
  od = __builtin_amdgcn_mfma_f32_32x32x16_bf16(pa3, PKV(l3, h3), od, 0, 0, 0);
#undef PKV
}
__device__ __forceinline__ void pv_d0(f32x16* o, int vb, bf16x8 pa0, bf16x8 pa1, bf16x8 pa2, bf16x8 pa3) {
  pv_one<0>(o[0], vb, pa0, pa1, pa2, pa3); pv_one<1>(o[1], vb, pa0, pa1, pa2, pa3); pv_one<2>(o[2], vb, pa0, pa1, pa2, pa3); pv_one<3>(o[3], vb, pa0, pa1, pa2, pa3);
}

__device__ __forceinline__ void attn_dense_body(const bf16_t* __restrict__ Qb, int ldq, const bf16_t* __restrict__ Kh, const bf16_t* __restrict__ Vh, int ldk,
                                                bf16_t* __restrict__ Ob, int ldo, int seq, char* lds) {
  const int tid = threadIdx.x, wid = tid >> 6, lane = tid & 63, r32 = lane & 31, hi = lane >> 5;
  char* V_lds = lds; char* K_lds = lds + 2 * SHM_V;
  float* ws = (float*)(lds + 2 * SHM_V + 2 * SHM_K) + wid * 64; float* li_l = ws; float* al_l = ws + 32;
  float m_reg = -1e30f, l_reg = 0; f32x16 o[4] = {}; bf16x8 qr[8];
  const bf16_t* Qw = Qb + (long)(wid * QBLK + r32) * ldq + hi * 8;
#pragma unroll
  for (int d0 = 0; d0 < 8; ++d0) qr[d0] = *reinterpret_cast<const bf16x8*>(Qw + d0 * 16);
  const int sr = tid >> 4, sc = (tid & 15) * 8, vst0 = v_st(sr, sc), vst1 = v_st(32 + sr, sc);
  const int vb0 = (int)(uintptr_t)V_lds + v_rd_base(lane);
  struct { bf16x8 vs0, vs1, ks0, ks1; } sr_[2];
#define SLOAD(i, k0) do { sr_[i].vs0 = *reinterpret_cast<const bf16x8*>(&Vh[(long)((k0) + sr) * ldk + sc]); sr_[i].vs1 = *reinterpret_cast<const bf16x8*>(&Vh[(long)((k0) + 32 + sr) * ldk + sc]); \
    sr_[i].ks0 = *reinterpret_cast<const bf16x8*>(&Kh[(long)((k0) + sr) * ldk + sc]); sr_[i].ks1 = *reinterpret_cast<const bf16x8*>(&Kh[(long)((k0) + 32 + sr) * ldk + sc]); } while (0)
#define SWRITE(b, i) do { *(bf16x8*)(V_lds + (b) * SHM_V + vst0) = sr_[i].vs0;          \
    *(bf16x8*)(V_lds + (b) * SHM_V + vst1) = sr_[i].vs1; int kc = sc * 2;               \
    *(bf16x8*)(K_lds + (b) * SHM_K + KSWZ(sr, kc)) = sr_[i].ks0;                       \
    *(bf16x8*)(K_lds + (b) * SHM_K + KSWZ(32 + sr, kc)) = sr_[i].ks1; } while (0)
#define SWAIT() asm volatile("s_waitcnt vmcnt(4)" ::: "memory")
#define RESC(a) do { if (__any((a) < 1.f)) { if (hi == 0) al_l[r32] = (a); asm volatile("s_waitcnt lgkmcnt(0)" ::: "memory"); \
    for (int d = 0; d < 4; ++d) for (int r = 0; r < 16; ++r) o[d][r] *= al_l[crow(r, hi)]; } } while (0)
  f32x16 pA0, pA1, pB0, pB1; float mnA, mnB, alA, alB; bf16x8 pa0, pa1, pa2, pa3; const int NT = seq / KVBLK;
  constexpr int SE = 0, SO = 1;
  SLOAD(SE, 0); asm volatile("s_waitcnt vmcnt(0)" ::: "memory"); SWRITE(0, SE); __syncthreads();
  qkt(pA0, pA1, K_lds, qr, r32, hi); partialSM(pA0, pA1, m_reg, mnA, alA);
  SLOAD(SO, KVBLK); if (2 < NT) SLOAD(SE, 2 * KVBLK);
  SWAIT(); SWRITE(1, SO); __syncthreads();
  for (int j = 1; j + 1 < NT; j += 2) {
    SBAR(); qkt(pB0, pB1, K_lds + SHM_K, qr, r32, hi);
    finishSM(pA0, pA1, alA, l_reg, pa0, pa1, pa2, pa3); SBAR();
    SLOAD(SO, (j + 2) * KVBLK); SBAR();
    pv_d0(o, vb0, pa0, pa1, pa2, pa3); partialSM(pB0, pB1, m_reg, mnB, alB);
    __syncthreads(); SWAIT(); SWRITE(0, SE);
    RESC(alB); __syncthreads();
    SBAR(); qkt(pA0, pA1, K_lds, qr, r32, hi);
    finishSM(pB0, pB1, alB, l_reg, pa0, pa1, pa2, pa3); SBAR();
    if (j + 3 < NT) SLOAD(SE, (j + 3) * KVBLK); SBAR();
    pv_d0(o, vb0 + (int)SHM_V, pa0, pa1, pa2, pa3); partialSM(pA0, pA1, m_reg, mnA, alA);
    __syncthreads(); SWAIT(); SWRITE(1, SO);
    RESC(alA); __syncthreads();
  }
  SBAR(); qkt(pB0, pB1, K_lds + SHM_K, qr, r32, hi);
  finishSM(pA0, pA1, alA, l_reg, pa0, pa1, pa2, pa3); SBAR();
  pv_d0(o, vb0, pa0, pa1, pa2, pa3); partialSM(pB0, pB1, m_reg, mnB, alB);
  __syncthreads(); RESC(alB);
  finishSM(pB0, pB1, alB, l_reg, pa0, pa1, pa2, pa3); SBAR();
  pv_d0(o, vb0 + (int)SHM_V, pa0, pa1, pa2, pa3);
  if (hi == 0) li_l[r32] = l_reg; asm volatile("s_waitcnt lgkmcnt(0)" ::: "memory");
  float rli[16];
#pragma unroll
  for (int r = 0; r < 16; ++r) rli[r] = __builtin_amdgcn_rcpf(li_l[crow(r, hi)]);
  bf16_t* Ow = Ob + (long)(wid * QBLK) * ldo;
#pragma unroll
  for (int r = 0; r < 16; ++r) { int orow = crow(r, hi);
#pragma unroll
    for (int d0 = 0; d0 < 4; ++d0) Ow[(long)orow * ldo + d0 * 32 + r32] = (bf16_t)(cvtpk(o[d0][r] * rli[r], 0.f) & 0xffffu); }
  __syncthreads();
#undef SWAIT
#undef RESC
}

template <bool MASK> __device__ __forceinline__ float sb_half(f32x16& p, int kvis, int hi, float Lbase) {
  constexpr float C = SCALE * 1.4426950408889634f;
  float f[16];
#pragma unroll
  for (int r = 0; r < 16; ++r) { const float z = p[r] * C, e = __builtin_amdgcn_exp2f(-fabsf(z)), lg = __builtin_amdgcn_logf(1.0f + e);
    const float lb = fminf(z, 0.f) - lg;
    const float lf = lb - z;
    if (MASK) { const bool vis = crow(r, hi) < kvis; f[r] = vis ? lf : 0.f; p[r] = vis ? lb : -1e30f; } else { f[r] = lf; p[r] = lb; } }
  float IS[5]; IS[4] = 0.f;
#pragma unroll
  for (int og = 3; og >= 0; --og) IS[og] = IS[og + 1] + ((f[4 * og] + f[4 * og + 1]) + (f[4 * og + 2] + f[4 * og + 3]));
  float PS[4];
#pragma unroll
  for (int og = 0; og < 4; ++og) { const float x = hi ? IS[og] : IS[og + 1]; auto rr = __builtin_amdgcn_permlane32_swap(__float_as_uint(x), __float_as_uint(x), false, false);
    PS[og] = hi ? __uint_as_float(rr[0]) : __uint_as_float(rr[1]); }
  float TP; { auto rr = __builtin_amdgcn_permlane32_swap(__float_as_uint(IS[0]), __float_as_uint(IS[0]), false, false); TP = hi ? __uint_as_float(rr[0]) : __uint_as_float(rr[1]); }
#pragma unroll
  for (int og = 0; og < 4; ++og) { const int b = 4 * og; float la = Lbase + IS[og + 1] + PS[og];
    p[b + 3] += la; la += f[b + 3]; p[b + 2] += la; la += f[b + 2]; p[b + 1] += la; la += f[b + 1]; p[b] += la; }
  return IS[0] + TP;
}
__device__ __forceinline__ void attn_sb_body(const bf16_t* __restrict__ Qb, const bf16_t* __restrict__ Kh, const bf16_t* __restrict__ Vh, int ld,
                                             bf16_t* __restrict__ Ob, int ldo, int qb, char* lds) {
  const int tid = threadIdx.x, wid = tid >> 6, lane = tid & 63, r32 = lane & 31, hi = lane >> 5;
  char* V_lds = lds; char* K_lds = lds + 2 * SHM_V;
  f32x16 o[4] = {}; bf16x8 qr[8];
  const bf16_t* Qw = Qb + (long)(wid * QBLK + r32) * ld + hi * 8;
#pragma unroll
  for (int d0 = 0; d0 < 8; ++d0) qr[d0] = *reinterpret_cast<const bf16x8*>(Qw + d0 * 16);
  const int vb0 = (int)(uintptr_t)V_lds + v_rd_base(lane);
  unsigned voffK[2], voffV[2];
#pragma unroll
  for (int i = 0; i < 2; ++i) { const int o = (tid + 512 * i) * 16;
    { const int row = o >> 8, colB = (o & 255) ^ ((row & 7) << 4); voffK[i] = (unsigned)(row * ld * 2 + colB); }
    { const int sub = o >> 9, in = (o & 511) >> 1, kk = (sub >> 2) * 8 + (in >> 5), c = (sub & 3) * 32 + (in & 31), k = (kk & ~0xC) | ((kk & 4) << 1) | ((kk & 8) >> 1); voffV[i] = (unsigned)(k * ld * 2 + c * 2); } }
  const unsigned ldsV = (unsigned)(uintptr_t)V_lds + (unsigned)__builtin_amdgcn_readfirstlane(wid) * 1024u, ldsK = ldsV + 3u * (unsigned)SHM_V;
#define SB_STAGE(b, k0) do { const char* kp_ = (const char*)(Kh + (long)(k0) * ld); const char* vp_ = (const char*)(Vh + (long)(k0) * ld); \
    pg8::glds16(kp_, voffK[0], ldsK + (unsigned)(b) * (unsigned)SHM_K); pg8::glds16(kp_, voffK[1], ldsK + (unsigned)(b) * (unsigned)SHM_K + 8192u); \
    pg8::glds16(vp_, voffV[0], ldsV + (unsigned)(b) * (unsigned)SHM_V); pg8::glds16(vp_, voffV[1], ldsV + (unsigned)(b) * (unsigned)SHM_V + 8192u); } while (0)
  const int NT = 4 * (qb + 1);
  const int t0w = qb * 256 + wid * QBLK;
  const int tq = t0w + r32;
  float L = 0.f;
  char* K3 = lds + 3 * SHM_V;
  int* done_l = (int*)(lds + 3 * SHM_V + 3 * SHM_K);
  SB_STAGE(0, (NT - 1) * KVBLK); SB_STAGE(1, (NT - 2) * KVBLK);
  asm volatile("s_waitcnt vmcnt(4)" ::: "memory"); __syncthreads();
  int buf = 0;
  for (int j = 0; j < NT; ++j) {
    const int s0 = (NT - 1 - j) * KVBLK;
    { const int b2 = buf >= 1 ? buf - 1 : 2; if (j + 2 < NT) SB_STAGE(b2, s0 - 2 * KVBLK); }
    if (s0 < t0w + QBLK && !__all(L < -152.0f)) {
      f32x16 p0, p1;
      qkt(p0, p1, K3 + buf * SHM_K, qr, r32, hi);
      const int kmax = tq - s0;
      float tot0, tot1;
      if (s0 + KVBLK <= t0w) { tot1 = sb_half<false>(p1, 64, hi, L); tot0 = sb_half<false>(p0, 64, hi, L + tot1); }
      else { tot1 = sb_half<true>(p1, kmax - 32, hi, L); tot0 = sb_half<true>(p0, kmax, hi, L + tot1); }
      L += tot0 + tot1;
#pragma unroll
      for (int r = 0; r < 16; ++r) { p0[r] = __builtin_amdgcn_exp2f(p0[r]); p1[r] = __builtin_amdgcn_exp2f(p1[r]); }
      bf16x8 pa0, pa1, pa2, pa3;
      PK4(p0, 0, pa0); PK4(p0, 8, pa1); PK4(p1, 0, pa2); PK4(p1, 8, pa3);
      SBAR();
      pv_d0(o, vb0 + buf * (int)SHM_V, pa0, pa1, pa2, pa3);
    }
    { const int wd = __all(L < -152.0f) ? 1 : 0; if (lane == 0) done_l[(j & 1) * 8 + wid] = wd; }
    if (j + 2 < NT) asm volatile("s_waitcnt vmcnt(4) lgkmcnt(0)" ::: "memory");
    else asm volatile("s_waitcnt vmcnt(0) lgkmcnt(0)" ::: "memory");
    __syncthreads();
    { int dn = 1;
#pragma unroll
      for (int w = 0; w < 8; ++w) dn &= done_l[(j & 1) * 8 + w];
      if (dn) break; }
    buf = buf == 2 ? 0 : buf + 1;
  }
  asm volatile("s_waitcnt vmcnt(0)" ::: "memory"); __syncthreads();
  bf16_t* Ow = Ob + (long)(wid * QBLK) * ldo;
#pragma unroll
  for (int r = 0; r < 16; ++r) { int orow = crow(r, hi);
#pragma unroll
    for (int d0 = 0; d0 < 4; ++d0) Ow[(long)orow * ldo + d0 * 32 + r32] = (bf16_t)(cvtpk(o[d0][r], 0.f) & 0xffffu); }
#undef SB_STAGE
}
#undef SLOAD
#undef SWRITE
}

#define XB_TMO      128
#define XB_XCNT(j)  (256  + 64 * (j))
#define XB_XSUB(j)  (1280 + 64 * (j))
#define XB_XGEN(j)  (2304 + 64 * (j))
#define XB_TOP      3328
#define XB_TOPGEN   3392
#define XCD_BAR_WORDS 3456
#define XB_SPIN_CAP (1u << 20)
__device__ __forceinline__ unsigned xb_ld(unsigned* p)              { return __hip_atomic_load(p, __ATOMIC_RELAXED, __HIP_MEMORY_SCOPE_AGENT); }
__device__ __forceinline__ unsigned xb_add(unsigned* p, unsigned v) { return __hip_atomic_fetch_add(p, v, __ATOMIC_RELAXED, __HIP_MEMORY_SCOPE_AGENT); }
__device__ __forceinline__ unsigned xb_xcc_id() { return (unsigned)__builtin_amdgcn_s_getreg((3 << 11) | 20) & 0xFu; }
#define XB_SPIN(cond, bar) do { unsigned _sp = 0; while (cond) { __builtin_amdgcn_s_sleep(1); \
    if ((++_sp & 255u) == 0u) { if (xb_ld(&(bar)[XB_TMO])) break; if (_sp > XB_SPIN_CAP) { atomicAdd(&(bar)[XB_TMO], 1u); break; } } } } while (0)
struct XcdBarrier { unsigned* bar; unsigned x; volatile LAS unsigned* st; };
__device__ __forceinline__ XcdBarrier xcd_barrier_post(unsigned* bar, volatile LAS unsigned* st) {
    XcdBarrier b; b.bar = bar; b.x = xb_xcc_id(); b.st = st;
    if (threadIdx.x == 0) (void)xb_add(&bar[XB_XCNT(b.x)], 1u);
    return b;
}
__device__ __forceinline__ void xcd_barrier_complete(unsigned* bar, unsigned x, unsigned& nloc, unsigned& nx) {
    const unsigned G = gridDim.x * gridDim.y * gridDim.z;
    unsigned sum, cnt, mine, sp = 0u;
    for (;;) {
        sum = 0u; cnt = 0u; mine = 0u;
#pragma unroll
        for (unsigned j = 0; j < 16; ++j) { const unsigned c = xb_ld(&bar[XB_XCNT(j)]); sum += c; cnt += (c > 0u) ? 1u : 0u; mine = (j == x) ? c : mine; }
        if (sum == G) break;
        __builtin_amdgcn_s_sleep(1);
        if ((++sp & 255u) == 0u) { if (xb_ld(&bar[XB_TMO])) break; if (sp > XB_SPIN_CAP) { atomicAdd(&bar[XB_TMO], 1u); break; } }
    }
    nloc = mine > 0u ? mine : 1u; nx = cnt > 0u ? cnt : 1u;
}
__device__ __forceinline__ void xcd_barrier(const XcdBarrier& b) {
    asm volatile("s_waitcnt vmcnt(0)" ::: "memory");
    __syncthreads();
    if (threadIdx.x == 0) {
        unsigned* bar = b.bar;
        __builtin_amdgcn_s_waitcnt(0);
        unsigned nloc = b.st[0], nx = b.st[1];
        if (nloc == 0u) { xcd_barrier_complete(bar, b.x, nloc, nx); b.st[0] = nloc; b.st[1] = nx; }
        const unsigned old = xb_add(&bar[XB_XSUB(b.x)], 1u);
        const unsigned gen = old / nloc;
        if (old + 1u == (gen + 1u) * nloc) {
            __builtin_amdgcn_fence(__ATOMIC_RELEASE, "agent");
            asm volatile("s_waitcnt vmcnt(0)" ::: "memory");
            const unsigned og = xb_add(&bar[XB_TOP], 1u);
            const unsigned tg = og / nx;
            if (og + 1u == (tg + 1u) * nx) xb_add(&bar[XB_TOPGEN], 1u);
            else XB_SPIN(xb_ld(&bar[XB_TOPGEN]) == tg, bar);
            __builtin_amdgcn_fence(__ATOMIC_ACQUIRE, "agent");
            xb_add(&bar[XB_XGEN(b.x)], 1u);
            asm volatile("s_waitcnt vmcnt(0)" ::: "memory");
        } else {
            XB_SPIN(xb_ld(&bar[XB_XGEN(b.x)]) == gen, bar);
            __builtin_amdgcn_fence(__ATOMIC_ACQUIRE, "agent");
            asm volatile("s_waitcnt vmcnt(0)" ::: "memory");
        }
    }
    __syncthreads();
}

struct Args { const float* in[22]; float* out; unsigned char* ws; int ph_lo, ph_hi; };
enum { I_X = 0, I_MEM, I_NMIXG, I_NMEMG, I_WIN, I_WPG, I_PSCALE, I_WPP, I_WSB, I_WKV, I_WMP, I_WOUT, I_NFFNG, I_WR, I_BR, I_WGATE, I_BGATE, I_WUP, I_BUP, I_WDOWN, I_BDOWN, I_NFING };

template <bool FP8> __device__ __forceinline__ void cvt_t_item(const float* W, int K, int N, void* WT, float scale, int item, int lane, int ldo = 0, int coff = 0) {
    if (ldo == 0) ldo = K;
    const int nkb = K / 16, nb = item / nkb, kb = item - nb * nkb, k0 = 16 * kb, n0 = 256 * nb + 4 * lane;
    f32x4 v[16];
#pragma unroll
    for (int r = 0; r < 16; ++r) v[r] = *(const f32x4*)(W + (size_t)(k0 + r) * N + n0);
#pragma unroll
    for (int j = 0; j < 4; ++j) {
        if constexpr (FP8) { u32x4 o; o.x = pg8::pk4_fp8(v[0][j] * scale, v[1][j] * scale, v[2][j] * scale, v[3][j] * scale); o.y = pg8::pk4_fp8(v[4][j] * scale, v[5][j] * scale, v[6][j] * scale, v[7][j] * scale);
            o.z = pg8::pk4_fp8(v[8][j] * scale, v[9][j] * scale, v[10][j] * scale, v[11][j] * scale); o.w = pg8::pk4_fp8(v[12][j] * scale, v[13][j] * scale, v[14][j] * scale, v[15][j] * scale);
            *(u32x4*)((unsigned char*)WT + (size_t)(n0 + j) * ldo + coff + k0) = o; }
        else { u32x4 o0, o1; o0.x = cvt_pk_bf16(v[0][j], v[1][j]); o0.y = cvt_pk_bf16(v[2][j], v[3][j]); o0.z = cvt_pk_bf16(v[4][j], v[5][j]); o0.w = cvt_pk_bf16(v[6][j], v[7][j]);
            o1.x = cvt_pk_bf16(v[8][j], v[9][j]); o1.y = cvt_pk_bf16(v[10][j], v[11][j]); o1.z = cvt_pk_bf16(v[12][j], v[13][j]); o1.w = cvt_pk_bf16(v[14][j], v[15][j]);
            u32x4* d = (u32x4*)((bf16_t*)WT + (size_t)(n0 + j) * ldo + coff + k0); d[0] = o0; d[1] = o1; }
    }
}
__device__ __forceinline__ void rms_row_to_bf16(const float* xrow, const float* g, bf16_t* orow, int lane, unsigned char* orow8 = nullptr) {
    const f32x4* xr = (const f32x4*)xrow + lane; const f32x4* gr = (const f32x4*)g + lane;
    f32x4 v[8]; float s = 0.f;
#pragma unroll
    for (int j = 0; j < 8; ++j) { v[j] = xr[64 * j]; s += (v[j].x * v[j].x + v[j].y * v[j].y) + (v[j].z * v[j].z + v[j].w * v[j].w); }
    const float rstd = 1.0f / sqrtf(wave_sum(s) * (1.f / DM) + EPS);
    u32x2* o8 = (u32x2*)orow + lane; unsigned* o4 = (unsigned*)orow8 + lane;
#pragma unroll
    for (int j = 0; j < 8; ++j) { const f32x4 gg = gr[64 * j]; const float a = v[j].x * rstd * gg.x, b = v[j].y * rstd * gg.y, c = v[j].z * rstd * gg.z, d = v[j].w * rstd * gg.w;
        u32x2 w; w.x = cvt_pk_bf16(a, b); w.y = cvt_pk_bf16(c, d); o8[64 * j] = w; if (orow8) o4[64 * j] = pg8::pk4_fp8(a, b, c, d); }
}

__device__ __forceinline__ void build_moe_tables(LAS int* tab, const unsigned* gcount) {
    if (threadIdx.x < NE) { int c = (int)__hip_atomic_load(gcount + threadIdx.x, __ATOMIC_RELAXED, __HIP_MEMORY_SCOPE_AGENT); if (c > CAP) c = CAP; tab[96 + threadIdx.x] = c; }
    __syncthreads();
    if (threadIdx.x == 0) {
        int cum1 = 0, cum2 = 0, tiles = 0;
        for (int e = 0; e < NE; ++e) { const int c = tab[96 + e]; const int ntm = (c + 255) >> 8;
            tab[32 + e] = ntm; tab[64 + e] = tiles; tiles += ntm; cum1 += ntm * 16; cum2 += ntm * 8; tab[e] = cum1; tab[128 + e] = cum2; }
        tab[160] = tiles;
    }
    __syncthreads();
}

__global__ void __launch_bounds__(NTHR, 2) fwd(Args args) {
    extern __shared__ __attribute__((aligned(16))) unsigned char lds_raw[];
    LAS unsigned char* lds = (LAS unsigned char*)lds_raw;
    volatile LAS unsigned* MISC = (volatile LAS unsigned*)(lds + LDS_MISC);
    LAS int* tab = (LAS int*)(lds + LDS_TAB);
    const int tid = threadIdx.x, lane = tid & 63, wave = __builtin_amdgcn_readfirstlane(tid >> 6);
    const int G = gridDim.x, bx = blockIdx.x, vcu = (G % 8 == 0) ? (bx % 8) * (G / 8) + bx / 8 : bx;
    unsigned char* ws = args.ws;
    unsigned* ctl = (unsigned*)(ws + WS_CTL);
    const int lo = args.ph_lo, hi = args.ph_hi;
    const bool multi = (hi - lo) > 1;
    if (tid < 32) MISC[tid] = 0u;
    __syncthreads();
    XcdBarrier bar; bar.bar = ctl + CW_BAR; bar.x = 0; bar.st = nullptr;
    if (multi) bar = xcd_barrier_post(ctl + CW_BAR, MISC + 8);
#define IN(k) (lo <= (k) && (k) < hi)
#define SEAM(k) do { if (IN(k) && IN((k) + 1)) xcd_barrier(bar); } while (0)
    const float* x = args.in[I_X];
    bf16_t* WinT = (bf16_t*)(ws + WS_WIN); unsigned char* WinG8 = ws + WS_WING8; unsigned char* XN8 = ws + WS_XN8; bf16_t* WmixT = (bf16_t*)(ws + WS_WMIX); bf16_t* WkvT = (bf16_t*)(ws + WS_WKV);
    bf16_t* WoutT = (bf16_t*)(ws + WS_WOUT); unsigned char* WgT = ws + WS_WG; unsigned char* WuT = ws + WS_WU; unsigned char* WdT = ws + WS_WD;
    bf16_t* Pb = (bf16_t*)(ws + WS_P); unsigned char* Act = ws + WS_ACT; bf16_t* XN = (bf16_t*)(ws + WS_XN); bf16_t* MEMN = (bf16_t*)(ws + WS_MEMN); bf16_t* KVXA = (bf16_t*)(ws + WS_KVXA);
    bf16_t* MIX = (bf16_t*)(ws + WS_MIX); bf16_t* MERGED = (bf16_t*)(ws + WS_MERGED);
    int* ROWSTOK = (int*)(ws + WS_ROWSTOK); float* GATEW = (float*)(ws + WS_GATEW); int* TOKSLOT = (int*)(ws + WS_TOKSLOT); unsigned char* Yb = ws + WS_Y;
    unsigned char* Gate8 = ws + WS_GATE8;
    unsigned* gcount = ctl + CW_GCOUNT; float* WRT = (float*)(ws + WS_WRT); float* RSTDW = (float*)(ws + WS_RSTDW);
    bf16_t* Hb = (bf16_t*)(ws + WS_XN);
    unsigned char* H8 = ws + WS_HN;
    const int gw = vcu * NWAVES + wave, NGW = G * NWAVES;

    if (IN(0)) {
        constexpr int I0 = (DM / 16) * (C_GATE / 256), I1 = (1024 / 16) * (DM / 256), I2 = (DM / 16) * (1024 / 256), I3 = (512 / 16) * (DM / 256), I4 = (DM / 16) * (DM / 256);
        for (int m = gw; m < MEMR; m += NGW) rms_row_to_bf16(args.in[I_MEM] + (size_t)m * DM, args.in[I_NMEMG], MEMN + (size_t)m * DM, lane);
        for (int it = gw; it < I2; it += NGW) cvt_t_item<false>(args.in[I_WKV], DM, 1024, WkvT, 1.f, it, lane);
        constexpr int NIT = I0 + I1 + I3 + I4;
        for (int it = gw; it < NIT; it += NGW) {
            int r = it;
            if (r < I0) { cvt_t_item<false>(args.in[I_WIN], DM, INW, WinT, 1.f, r, lane); continue; } r -= I0;
            if (r < I1) { cvt_t_item<false>(args.in[I_WSB], 1024, DM, WmixT, 1.f, r, lane, DM, 512); continue; } r -= I1;
            if (r < I3) { cvt_t_item<false>(args.in[I_WMP], 512, DM, WmixT, 1.f, r, lane, DM, 1536); continue; } r -= I3;
            cvt_t_item<false>(args.in[I_WOUT], DM, DM, WoutT, 1.f, r, lane);
        }
        for (int it = gw; it < 4 * 4 * 64; it += NGW) {
            const int g = it >> 8, cb = (it >> 6) & 3, nb = it & 63, r32 = lane & 31, hh = lane >> 5;
            const float* Wgp = args.in[I_WPG] + ((size_t)g * 128 + cb * 32 + r32) * 128 + 4 * hh;
            const float* scp = args.in[I_PSCALE] + g * 128 + 4 * hh;
            const float* Wpp = args.in[I_WPP] + ((size_t)g * 128 + 4 * hh) * DM + nb * 32 + r32;
            f32x16 acc = {};
            f32x4 a4[16], s4[16]; float bq[16][4];
#pragma unroll
            for (int s8 = 0; s8 < 16; ++s8) { a4[s8] = *(const f32x4*)(Wgp + 8 * s8); s4[s8] = *(const f32x4*)(scp + 8 * s8);
#pragma unroll
                for (int j = 0; j < 4; ++j) bq[s8][j] = Wpp[(size_t)(8 * s8 + j) * DM]; }
#pragma unroll
            for (int s8 = 0; s8 < 16; ++s8)
#pragma unroll
                for (int j = 0; j < 4; ++j) acc = __builtin_amdgcn_mfma_f32_32x32x2f32(a4[s8][j], s4[s8][j] * bq[s8][j], acc, 0, 0, 0);
            bf16_t* dst = WmixT + (size_t)(nb * 32 + r32) * DM + g * 128 + cb * 32 + 4 * hh;
#pragma unroll
            for (int q = 0; q < 4; ++q) { u32x2 w; w.x = cvt_pk_bf16(acc[4 * q], acc[4 * q + 1]); w.y = cvt_pk_bf16(acc[4 * q + 2], acc[4 * q + 3]); *(u32x2*)(dst + 8 * q) = w; }
        }
        for (int i = gw * 64 + lane; i < NE * DM; i += NGW * 64) { const int e = i >> 11, k = i & (DM - 1); WRT[i] = args.in[I_WR][(size_t)k * NE + e] * args.in[I_NFFNG][k]; }
        for (int m = gw; m < T; m += NGW) rms_row_to_bf16(x + (size_t)m * DM, args.in[I_NMIXG], XN + (size_t)m * DM, lane, XN8 + (size_t)m * DM);
        __syncthreads();
        {
            constexpr int NWX = 3 * NE * 128, NWI = NWX + 16 * 24;
            const int nitems = (NWI - NWX - vcu + G - 1) / G;
#define CV_ITEM(i) (NWX + vcu + (i) * G)
            LAS float* gsc = (LAS float*)(lds + 65536);
            for (int k = tid; k < DM; k += NTHR) gsc[k] = pg8::W_SCALE * args.in[I_NFFNG][k];
            __syncthreads();
            const int n4 = 4 * lane;
            f32x4 vA[16], vB[16];
#define CV_LOAD(v, item) do { const float* src_; size_t ns_; if ((item) < NWX) { const int mat_ = (item) >> 7, r_ = (item) & 127, nb_ = r_ & 7, kg_ = r_ >> 3, which_ = mat_ >> 5, e_ = mat_ & 31; ns_ = DFF; \
                    src_ = args.in[which_ == 0 ? I_WGATE : (which_ == 1 ? I_WUP : I_WDOWN)] + (size_t)e_ * DM * DFF + (size_t)(128 * kg_ + 16 * wave) * DFF + 256 * nb_ + n4; } \
                else { const int r_ = (item) - NWX, nb_ = r_ % 24, kg_ = r_ / 24; ns_ = INW; src_ = args.in[I_WIN] + (size_t)(128 * kg_ + 16 * wave) * INW + C_GATE + 256 * nb_ + n4; } \
                _Pragma("unroll") for (int r = 0; r < 16; ++r) v[r] = __builtin_nontemporal_load((const f32x4*)(src_ + (size_t)r * ns_)); } while (0)
#define CV_STEP(v, it, bsel, has_n, itn) do { LAS unsigned char* buf = lds + (bsel) * 32768; \
                { float ms[16]; const bool fold = (it) < 2 * NE * 128; const int kr0 = ((it) < NWX ? 128 * (((it) & 127) >> 3) : 0) + 16 * wave; \
                  _Pragma("unroll") for (int r = 0; r < 16; ++r) { const float gq_ = gsc[kr0 + r]; ms[r] = fold ? gq_ : pg8::W_SCALE; } \
                  _Pragma("unroll") for (int j = 0; j < 4; ++j) { u32x4 o; o.x = pg8::pk4_fp8(v[0][j] * ms[0], v[1][j] * ms[1], v[2][j] * ms[2], v[3][j] * ms[3]); o.y = pg8::pk4_fp8(v[4][j] * ms[4], v[5][j] * ms[5], v[6][j] * ms[6], v[7][j] * ms[7]); \
                    o.z = pg8::pk4_fp8(v[8][j] * ms[8], v[9][j] * ms[9], v[10][j] * ms[10], v[11][j] * ms[11]); o.w = pg8::pk4_fp8(v[12][j] * ms[12], v[13][j] * ms[13], v[14][j] * ms[14], v[15][j] * ms[15]); \
                    *(LAS u32x4*)(buf + (n4 + j) * 128 + ((wave ^ (lane & 7)) << 4)) = o; } } \
                const int mat = (it) >> 7, r7 = (it) & 127, which = mat >> 5, e = mat & 31; \
                const int nb = (it) < NWX ? (r7 & 7) : ((it) - NWX) % 24, kg = (it) < NWX ? (r7 >> 3) : ((it) - NWX) / 24; \
                CV_LOAD(v, itn); \
                __syncthreads(); \
                unsigned char* dst = ((it) < NWX ? (which == 0 ? WgT : (which == 1 ? WuT : WdT)) + (size_t)e * DM * DFF : WinG8) + (size_t)(256 * nb) * DM + 128 * kg + 16 * (lane & 7); \
                _Pragma("unroll") for (int q4 = 0; q4 < 4; ++q4) { const int row = wave * 32 + q4 * 8 + (lane >> 3);     \
                    const u32x4 o = *(const LAS u32x4*)(buf + row * 128 + (((lane & 7) ^ ((row >> 2) & 7)) << 4)); *(u32x4*)(dst + (size_t)row * DM) = o; } } while (0)
#define CV_CL(i_) CV_ITEM((i_) < nitems ? (i_) : nitems - 1)
            if (nitems > 0) { CV_LOAD(vA, CV_CL(0)); CV_LOAD(vB, CV_CL(1));
                for (int i = 0; i < nitems; i += 2) {
                    { const int it = CV_CL(i); CV_STEP(vA, it, 0, true, CV_CL(i + 2)); }
                    { const int it = CV_CL(i + 1); CV_STEP(vB, it, 1, true, CV_CL(i + 3)); }
                } }
#undef CV_CL
#undef CV_STEP
#undef CV_LOAD
#undef CV_ITEM
            __syncthreads();
        }
    }
    SEAM(0);

    if (IN(1))
    {
        const bool mkwg = bx < 32; const int grp = (G == 256) ? ((bx >> 3) & 31) % 3 : 0;
        if (mkwg) { pg8::DenseProb P; P.init(MEMN, WkvT, MEMR, 1024, DM, G, bx); pg8::EpiStoreBf16 E{KVXA, 1024, 1 << 30, 1.f}; pg8::gemm_phase(lds, P, E); }
        if (grp == 0) {
        {
            constexpr int NWX = 3 * NE * 128, NWI = NWX + 16 * 24;
            const bool stag = (G == 256);
            const int b5 = vcu & 31, a5 = vcu >> 5, cntg = (31 - grp) / 3 + 1, ng = stag ? cntg * (G >> 5) : G, q = stag ? a5 * cntg + b5 / 3 : vcu;
            const int ibase = stag ? (int)((long)NWX * (grp == 0 ? 0 : (grp == 1 ? 11 : 22)) / 32) : 0, iend = stag ? (int)((long)NWX * (grp == 0 ? 11 : (grp == 1 ? 22 : 32)) / 32) : NWX;
            const int nitems = (iend - ibase - q + ng - 1) / ng;
#define CV_ITEM(i) (ibase + q + (i) * ng)
            LAS float* gsc = (LAS float*)(lds + 65536);
            for (int k = tid; k < DM; k += NTHR) gsc[k] = pg8::W_SCALE * args.in[I_NFFNG][k];
            __syncthreads();
            const int n4 = 4 * lane;
            f32x4 vA[16], vB[16];
#define CV_LOAD(v, item) do { const float* src_; size_t ns_; if ((item) < NWX) { const int mat_ = (item) >> 7, r_ = (item) & 127, nb_ = r_ & 7, kg_ = r_ >> 3, which_ = mat_ >> 5, e_ = mat_ & 31; ns_ = DFF; \
                    src_ = args.in[which_ == 0 ? I_WGATE : (which_ == 1 ? I_WUP : I_WDOWN)] + (size_t)e_ * DM * DFF + (size_t)(128 * kg_ + 16 * wave) * DFF + 256 * nb_ + n4; } \
                else { const int r_ = (item) - NWX, nb_ = r_ % 24, kg_ = r_ / 24; ns_ = INW; src_ = args.in[I_WIN] + (size_t)(128 * kg_ + 16 * wave) * INW + C_GATE + 256 * nb_ + n4; } \
                _Pragma("unroll") for (int r = 0; r < 16; ++r) v[r] = __builtin_nontemporal_load((const f32x4*)(src_ + (size_t)r * ns_)); } while (0)
#define CV_STEP(v, it, bsel, has_n, itn) do { LAS unsigned char* buf = lds + (bsel) * 32768; \
                { float ms[16]; const bool fold = (it) < 2 * NE * 128; const int kr0 = ((it) < NWX ? 128 * (((it) & 127) >> 3) : 0) + 16 * wave; \
                  _Pragma("unroll") for (int r = 0; r < 16; ++r) { const float gq_ = gsc[kr0 + r]; ms[r] = fold ? gq_ : pg8::W_SCALE; } \
                  _Pragma("unroll") for (int j = 0; j < 4; ++j) { u32x4 o; o.x = pg8::pk4_fp8(v[0][j] * ms[0], v[1][j] * ms[1], v[2][j] * ms[2], v[3][j] * ms[3]); o.y = pg8::pk4_fp8(v[4][j] * ms[4], v[5][j] * ms[5], v[6][j] * ms[6], v[7][j] * ms[7]); \
                    o.z = pg8::pk4_fp8(v[8][j] * ms[8], v[9][j] * ms[9], v[10][j] * ms[10], v[11][j] * ms[11]); o.w = pg8::pk4_fp8(v[12][j] * ms[12], v[13][j] * ms[13], v[14][j] * ms[14], v[15][j] * ms[15]); \
                    *(LAS u32x4*)(buf + (n4 + j) * 128 + ((wave ^ (lane & 7)) << 4)) = o; } } \
                const int mat = (it) >> 7, r7 = (it) & 127, which = mat >> 5, e = mat & 31; \
                const int nb = (it) < NWX ? (r7 & 7) : ((it) - NWX) % 24, kg = (it) < NWX ? (r7 >> 3) : ((it) - NWX) / 24; \
                CV_LOAD(v, itn); \
                __syncthreads(); \
                unsigned char* dst = ((it) < NWX ? (which == 0 ? WgT : (which == 1 ? WuT : WdT)) + (size_t)e * DM * DFF : WinG8) + (size_t)(256 * nb) * DM + 128 * kg + 16 * (lane & 7); \
                _Pragma("unroll") for (int q4 = 0; q4 < 4; ++q4) { const int row = wave * 32 + q4 * 8 + (lane >> 3);     \
                    const u32x4 o = *(const LAS u32x4*)(buf + row * 128 + (((lane & 7) ^ ((row >> 2) & 7)) << 4)); *(u32x4*)(dst + (size_t)row * DM) = o; } } while (0)
#define CV_CL(i_) CV_ITEM((i_) < nitems ? (i_) : nitems - 1)
            if (nitems > 0) { CV_LOAD(vA, CV_CL(0)); CV_LOAD(vB, CV_CL(1));
                for (int i = 0; i < nitems; i += 2) {
                    { const int it = CV_CL(i); CV_STEP(vA, it, 0, true, CV_CL(i + 2)); }
                    { const int it = CV_CL(i + 1); CV_STEP(vB, it, 1, true, CV_CL(i + 3)); }
                } }
#undef CV_CL
#undef CV_STEP
#undef CV_LOAD
#undef CV_ITEM
            __syncthreads();
        }
        }
        { pg8::DenseProb P; P.init(XN, WinT, T, C_GATE, DM, G, bx); pg8::EpiStoreBf16 E{Pb, INW, 1 << 30, 1.f}; pg8::gemm_phase(lds, P, E); }
        if (grp == 1) {
        {
            constexpr int NWX = 3 * NE * 128, NWI = NWX + 16 * 24;
            const bool stag = (G == 256);
            const int b5 = vcu & 31, a5 = vcu >> 5, cntg = (31 - grp) / 3 + 1, ng = stag ? cntg * (G >> 5) : G, q = stag ? a5 * cntg + b5 / 3 : vcu;
            const int ibase = stag ? (int)((long)NWX * (grp == 0 ? 0 : (grp == 1 ? 11 : 22)) / 32) : 0, iend = stag ? (int)((long)NWX * (grp == 0 ? 11 : (grp == 1 ? 22 : 32)) / 32) : NWX;
            const int nitems = (iend - ibase - q + ng - 1) / ng;
#define CV_ITEM(i) (ibase + q + (i) * ng)
            LAS float* gsc = (LAS float*)(lds + 65536);
            for (int k = tid; k < DM; k += NTHR) gsc[k] = pg8::W_SCALE * args.in[I_NFFNG][k];
            __syncthreads();
            const int n4 = 4 * lane;
            f32x4 vA[16], vB[16];
#define CV_LOAD(v, item) do { const float* src_; size_t ns_; if ((item) < NWX) { const int mat_ = (item) >> 7, r_ = (item) & 127, nb_ = r_ & 7, kg_ = r_ >> 3, which_ = mat_ >> 5, e_ = mat_ & 31; ns_ = DFF; \
                    src_ = args.in[which_ == 0 ? I_WGATE : (which_ == 1 ? I_WUP : I_WDOWN)] + (size_t)e_ * DM * DFF + (size_t)(128 * kg_ + 16 * wave) * DFF + 256 * nb_ + n4; } \
                else { const int r_ = (item) - NWX, nb_ = r_ % 24, kg_ = r_ / 24; ns_ = INW; src_ = args.in[I_WIN] + (size_t)(128 * kg_ + 16 * wave) * INW + C_GATE + 256 * nb_ + n4; } \
                _Pragma("unroll") for (int r = 0; r < 16; ++r) v[r] = __builtin_nontemporal_load((const f32x4*)(src_ + (size_t)r * ns_)); } while (0)
#define CV_STEP(v, it, bsel, has_n, itn) do { LAS unsigned char* buf = lds + (bsel) * 32768; \
                { float ms[16]; const bool fold = (it) < 2 * NE * 128; const int kr0 = ((it) < NWX ? 128 * (((it) & 127) >> 3) : 0) + 16 * wave; \
                  _Pragma("unroll") for (int r = 0; r < 16; ++r) { const float gq_ = gsc[kr0 + r]; ms[r] = fold ? gq_ : pg8::W_SCALE; } \
                  _Pragma("unroll") for (int j = 0; j < 4; ++j) { u32x4 o; o.x = pg8::pk4_fp8(v[0][j] * ms[0], v[1][j] * ms[1], v[2][j] * ms[2], v[3][j] * ms[3]); o.y = pg8::pk4_fp8(v[4][j] * ms[4], v[5][j] * ms[5], v[6][j] * ms[6], v[7][j] * ms[7]); \
                    o.z = pg8::pk4_fp8(v[8][j] * ms[8], v[9][j] * ms[9], v[10][j] * ms[10], v[11][j] * ms[11]); o.w = pg8::pk4_fp8(v[12][j] * ms[12], v[13][j] * ms[13], v[14][j] * ms[14], v[15][j] * ms[15]); \
                    *(LAS u32x4*)(buf + (n4 + j) * 128 + ((wave ^ (lane & 7)) << 4)) = o; } } \
                const int mat = (it) >> 7, r7 = (it) & 127, which = mat >> 5, e = mat & 31; \
                const int nb = (it) < NWX ? (r7 & 7) : ((it) - NWX) % 24, kg = (it) < NWX ? (r7 >> 3) : ((it) - NWX) / 24; \
                CV_LOAD(v, itn); \
                __syncthreads(); \
                unsigned char* dst = ((it) < NWX ? (which == 0 ? WgT : (which == 1 ? WuT : WdT)) + (size_t)e * DM * DFF : WinG8) + (size_t)(256 * nb) * DM + 128 * kg + 16 * (lane & 7); \
                _Pragma("unroll") for (int q4 = 0; q4 < 4; ++q4) { const int row = wave * 32 + q4 * 8 + (lane >> 3);     \
                    const u32x4 o = *(const LAS u32x4*)(buf + row * 128 + (((lane & 7) ^ ((row >> 2) & 7)) << 4)); *(u32x4*)(dst + (size_t)row * DM) = o; } } while (0)
#define CV_CL(i_) CV_ITEM((i_) < nitems ? (i_) : nitems - 1)
            if (nitems > 0) { CV_LOAD(vA, CV_CL(0)); CV_LOAD(vB, CV_CL(1));
                for (int i = 0; i < nitems; i += 2) {
                    { const int it = CV_CL(i); CV_STEP(vA, it, 0, true, CV_CL(i + 2)); }
                    { const int it = CV_CL(i + 1); CV_STEP(vB, it, 1, true, CV_CL(i + 3)); }
                } }
#undef CV_CL
#undef CV_STEP
#undef CV_LOAD
#undef CV_ITEM
            __syncthreads();
        }
        }
        { pg8::DenseProb8 P; P.init(XN8, WinG8, T, INW - C_GATE, DM, G, bx); pg8::EpiGateU8 E{Gate8, 1.0f / pg8::W_SCALE}; pg8::gemm_phase(lds, P, E); }
        if (grp == 2) {
        {
            constexpr int NWX = 3 * NE * 128, NWI = NWX + 16 * 24;
            const bool stag = (G == 256);
            const int b5 = vcu & 31, a5 = vcu >> 5, cntg = (31 - grp) / 3 + 1, ng = stag ? cntg * (G >> 5) : G, q = stag ? a5 * cntg + b5 / 3 : vcu;
            const int ibase = stag ? (int)((long)NWX * (grp == 0 ? 0 : (grp == 1 ? 11 : 22)) / 32) : 0, iend = stag ? (int)((long)NWX * (grp == 0 ? 11 : (grp == 1 ? 22 : 32)) / 32) : NWX;
            const int nitems = (iend - ibase - q + ng - 1) / ng;
#define CV_ITEM(i) (ibase + q + (i) * ng)
            LAS float* gsc = (LAS float*)(lds + 65536);
            for (int k = tid; k < DM; k += NTHR) gsc[k] = pg8::W_SCALE * args.in[I_NFFNG][k];
            __syncthreads();
            const int n4 = 4 * lane;
            f32x4 vA[16], vB[16];
#define CV_LOAD(v, item) do { const float* src_; size_t ns_; if ((item) < NWX) { const int mat_ = (item) >> 7, r_ = (item) & 127, nb_ = r_ & 7, kg_ = r_ >> 3, which_ = mat_ >> 5, e_ = mat_ & 31; ns_ = DFF; \
                    src_ = args.in[which_ == 0 ? I_WGATE : (which_ == 1 ? I_WUP : I_WDOWN)] + (size_t)e_ * DM * DFF + (size_t)(128 * kg_ + 16 * wave) * DFF + 256 * nb_ + n4; } \
                else { const int r_ = (item) - NWX, nb_ = r_ % 24, kg_ = r_ / 24; ns_ = INW; src_ = args.in[I_WIN] + (size_t)(128 * kg_ + 16 * wave) * INW + C_GATE + 256 * nb_ + n4; } \
                _Pragma("unroll") for (int r = 0; r < 16; ++r) v[r] = __builtin_nontemporal_load((const f32x4*)(src_ + (size_t)r * ns_)); } while (0)
#define CV_STEP(v, it, bsel, has_n, itn) do { LAS unsigned char* buf = lds + (bsel) * 32768; \
                { float ms[16]; const bool fold = (it) < 2 * NE * 128; const int kr0 = ((it) < NWX ? 128 * (((it) & 127) >> 3) : 0) + 16 * wave; \
                  _Pragma("unroll") for (int r = 0; r < 16; ++r) { const float gq_ = gsc[kr0 + r]; ms[r] = fold ? gq_ : pg8::W_SCALE; } \
                  _Pragma("unroll") for (int j = 0; j < 4; ++j) { u32x4 o; o.x = pg8::pk4_fp8(v[0][j] * ms[0], v[1][j] * ms[1], v[2][j] * ms[2], v[3][j] * ms[3]); o.y = pg8::pk4_fp8(v[4][j] * ms[4], v[5][j] * ms[5], v[6][j] * ms[6], v[7][j] * ms[7]); \
                    o.z = pg8::pk4_fp8(v[8][j] * ms[8], v[9][j] * ms[9], v[10][j] * ms[10], v[11][j] * ms[11]); o.w = pg8::pk4_fp8(v[12][j] * ms[12], v[13][j] * ms[13], v[14][j] * ms[14], v[15][j] * ms[15]); \
                    *(LAS u32x4*)(buf + (n4 + j) * 128 + ((wave ^ (lane & 7)) << 4)) = o; } } \
                const int mat = (it) >> 7, r7 = (it) & 127, which = mat >> 5, e = mat & 31; \
                const int nb = (it) < NWX ? (r7 & 7) : ((it) - NWX) % 24, kg = (it) < NWX ? (r7 >> 3) : ((it) - NWX) / 24; \
                CV_LOAD(v, itn); \
                __syncthreads(); \
                unsigned char* dst = ((it) < NWX ? (which == 0 ? WgT : (which == 1 ? WuT : WdT)) + (size_t)e * DM * DFF : WinG8) + (size_t)(256 * nb) * DM + 128 * kg + 16 * (lane & 7); \
                _Pragma("unroll") for (int q4 = 0; q4 < 4; ++q4) { const int row = wave * 32 + q4 * 8 + (lane >> 3);     \
                    const u32x4 o = *(const LAS u32x4*)(buf + row * 128 + (((lane & 7) ^ ((row >> 2) & 7)) << 4)); *(u32x4*)(dst + (size_t)row * DM) = o; } } while (0)
#define CV_CL(i_) CV_ITEM((i_) < nitems ? (i_) : nitems - 1)
            if (nitems > 0) { CV_LOAD(vA, CV_CL(0)); CV_LOAD(vB, CV_CL(1));
                for (int i = 0; i < nitems; i += 2) {
                    { const int it = CV_CL(i); CV_STEP(vA, it, 0, true, CV_CL(i + 2)); }
                    { const int it = CV_CL(i + 1); CV_STEP(vB, it, 1, true, CV_CL(i + 3)); }
                } }
#undef CV_CL
#undef CV_STEP
#undef CV_LOAD
#undef CV_ITEM
            __syncthreads();
        }
        }
    }
    SEAM(1);

    if (IN(2)) {
        for (int u = vcu; u < 256; u += G) {
            const int bh = u >> 2, jp = u & 3, b = bh >> 3, h = bh & 7;
            const bf16_t* base = Pb + (size_t)b * SEQ * INW + h * 128;
#pragma unroll 1
            for (int s = 0; s < 2; ++s) { const int qb = s ? 7 - jp : jp;
                att::attn_sb_body(base + C_QSB + (size_t)qb * 256 * INW, base + C_KSB, base + C_VSB, INW, MIX + ((size_t)b * SEQ + qb * 256) * DM + 512 + h * 128, DM, qb, (char*)lds_raw); }
        }
        for (int u = vcu; u < 256; u += G) {
            const int b = u >> 5, h = (u >> 3) & 3, qb = u & 7;
            att::attn_dense_body(Pb + ((size_t)b * SEQ + qb * 256) * INW + C_QXA + h * 128, INW, KVXA + (size_t)b * NMEM * 1024 + h * 128, KVXA + (size_t)b * NMEM * 1024 + 512 + h * 128, 1024,
                                 MIX + ((size_t)b * SEQ + qb * 256) * DM + 1536 + h * 128, DM, NMEM, (char*)lds_raw);
        }
#define POOL_GROUP(G_, W_) for (int it = vcu * NTHR + tid; it < T * 16; it += G * NTHR) { const int row = it >> 4, ch = (G_) * 128 + (it & 15) * 8, t = row & (SEQ - 1); \
            u32x4 vv[W_]; _Pragma("unroll") for (int j = 0; j < (W_); ++j) vv[j] = (j <= t) ? *(const u32x4*)(Pb + (size_t)(row - j) * INW + C_POOL + ch) : (u32x4){0u, 0u, 0u, 0u}; \
            float s8[8]; _Pragma("unroll") for (int k = 0; k < 8; ++k) s8[k] = 0.f; \
            _Pragma("unroll") for (int j = 0; j < (W_); ++j) { s8[0] += bf_lo(vv[j].x); s8[1] += bf_hi(vv[j].x); s8[2] += bf_lo(vv[j].y); s8[3] += bf_hi(vv[j].y); s8[4] += bf_lo(vv[j].z); s8[5] += bf_hi(vv[j].z); s8[6] += bf_lo(vv[j].w); s8[7] += bf_hi(vv[j].w); } \
            const float inv = 1.0f / (float)((t + 1 < (W_)) ? t + 1 : (W_)); const u32x4 cur = vv[0]; \
            u32x4 o; o.x = cvt_pk_bf16(s8[0] * inv - bf_lo(cur.x), s8[1] * inv - bf_hi(cur.x)); o.y = cvt_pk_bf16(s8[2] * inv - bf_lo(cur.y), s8[3] * inv - bf_hi(cur.y)); \
            o.z = cvt_pk_bf16(s8[4] * inv - bf_lo(cur.z), s8[5] * inv - bf_hi(cur.z)); o.w = cvt_pk_bf16(s8[6] * inv - bf_lo(cur.w), s8[7] * inv - bf_hi(cur.w)); \
            *(u32x4*)(MIX + (size_t)row * DM + ch) = o; }
        POOL_GROUP(0, 2) POOL_GROUP(1, 4) POOL_GROUP(2, 8) POOL_GROUP(3, 16)
#undef POOL_GROUP
        __syncthreads();
    }
    SEAM(2);

    if (IN(3))
    {
        { pg8::DenseProb P; P.init(MIX, WmixT, T, DM, DM, G, bx); pg8::EpiMix E{MERGED, Gate8}; pg8::gemm_phase(lds, P, E); }
    }
    SEAM(3);

    if (IN(4))
    {
        pg8::DenseProb P; P.init(MERGED, WoutT, T, DM, DM, G, bx); pg8::EpiResid8 E{x, Hb, H8}; pg8::gemm_phase(lds, P, E);
    }
    SEAM(4);

    if (IN(5)) {
        LAS float* tile = (LAS float*)lds;
        LAS float* ssq = (LAS float*)(lds + 40960);
        LAS int* hist = (LAS int*)(lds + 45056);
        LAS int* sel = (LAS int*)(lds + 45568);
        LAS float* selp = (LAS float*)(lds + 45568 + 2048);
        LAS float* rstd_l = (LAS float*)(lds + 45568 + 3072);
        const float* br = args.in[I_BR];
        const int r32 = lane & 31, hh = lane >> 5, rb = wave & 1, kq = wave >> 1;
        for (int u = vcu; u < T / 64; u += G) {
            const int row0 = u * 64;
            if (tid < 32) hist[tid] = 0;
            f32x16 acc = {}; float ss = 0.f;
            const bf16_t* hrow = Hb + (size_t)(row0 + 32 * rb + r32) * DM;
            const float* wrow = WRT + (size_t)r32 * DM;
            u32x4 qa[4][2]; f32x4 qb[4][4];
#define RT_LOAD(slot, sg_) do { const int kb_ = 512 * kq + 32 * (sg_) + 16 * hh; qa[slot][0] = *(const u32x4*)(hrow + kb_); qa[slot][1] = *(const u32x4*)(hrow + kb_ + 8); \
                _Pragma("unroll") for (int q = 0; q < 4; ++q) qb[slot][q] = *(const f32x4*)(wrow + kb_ + 4 * q); } while (0)
#define RT_MMA(slot) do { _Pragma("unroll") for (int j = 0; j < 16; ++j) { const unsigned w_ = qa[slot][j >> 3][(j >> 1) & 3]; const float av = (j & 1) ? bf_hi(w_) : bf_lo(w_); \
                acc = __builtin_amdgcn_mfma_f32_32x32x2f32(av, qb[slot][j >> 2][j & 3], acc, 0, 0, 0); ss += av * av; } } while (0)
            RT_LOAD(0, 0); RT_LOAD(1, 1); RT_LOAD(2, 2);
#pragma unroll 1
            for (int sg = 0; sg < 16; sg += 4) {
                __builtin_amdgcn_sched_barrier(0); RT_LOAD(3, sg + 3); __builtin_amdgcn_sched_barrier(0); RT_MMA(0);
                __builtin_amdgcn_sched_barrier(0); if (sg + 4 < 16) RT_LOAD(0, sg + 4); __builtin_amdgcn_sched_barrier(0); RT_MMA(1);
                __builtin_amdgcn_sched_barrier(0); if (sg + 5 < 16) RT_LOAD(1, sg + 5); __builtin_amdgcn_sched_barrier(0); RT_MMA(2);
                __builtin_amdgcn_sched_barrier(0); if (sg + 6 < 16) RT_LOAD(2, sg + 6); __builtin_amdgcn_sched_barrier(0); RT_MMA(3);
            }
#undef RT_LOAD
#undef RT_MMA
#pragma unroll
            for (int r = 0; r < 16; ++r) tile[((kq * 2 + rb) * 32 + att::crow(r, hh)) * 33 + r32] = acc[r];
            ssq[((kq * 2 + rb) * 2 + hh) * 32 + r32] = ss;
            __syncthreads();
            if (tid < 64) {
                const int rbb = tid >> 5, r = tid & 31; float sq = 0.f;
#pragma unroll
                for (int q = 0; q < 4; ++q) sq += ssq[((q * 2 + rbb) * 2 + 0) * 32 + r] + ssq[((q * 2 + rbb) * 2 + 1) * 32 + r];
                const float rstd = 1.0f / sqrtf(sq * (1.f / DM) + EPS);
                float lg[NE];
#pragma unroll
                for (int e = 0; e < NE; ++e) { float s = 0.f;
#pragma unroll
                    for (int q = 0; q < 4; ++q) s += tile[((q * 2 + rbb) * 32 + r) * 33 + e];
                    lg[e] = s * rstd + br[e]; }
                int ti[TOPK]; float tv[TOPK];
#pragma unroll
                for (int k = 0; k < TOPK; ++k) { float bv = -3.0e38f; int bi = 0;
#pragma unroll
                    for (int e = 0; e < NE; ++e) { const bool better = lg[e] > bv; bv = better ? lg[e] : bv; bi = better ? e : bi; }
                    ti[k] = bi; tv[k] = bv;
#pragma unroll
                    for (int e = 0; e < NE; ++e) lg[e] = (e == bi) ? -3.0e38f : lg[e]; }
                float pe[TOPK], psum = 0.f;
#pragma unroll
                for (int k = 0; k < TOPK; ++k) { pe[k] = __expf(tv[k] - tv[0]); psum += pe[k]; }
                const float pinv = 1.0f / psum;
#pragma unroll
                for (int k = 0; k < TOPK; ++k) { sel[tid * 4 + k] = ti[k]; sel[256 + tid * 4 + k] = __hip_atomic_fetch_add(&hist[ti[k]], 1, __ATOMIC_RELAXED, __HIP_MEMORY_SCOPE_WORKGROUP); selp[tid * 4 + k] = pe[k] * pinv; }
                rstd_l[tid] = rstd;
            }
            __syncthreads();
            if (tid < 32) { const int c = hist[tid]; hist[32 + tid] = c ? (int)atomicAdd(gcount + tid, (unsigned)c) : 0; }
            __syncthreads();
            if (tid < 64) {
#pragma unroll
                for (int k = 0; k < TOPK; ++k) { const int e = sel[tid * 4 + k]; int rank = hist[32 + e] + sel[256 + tid * 4 + k]; if (rank >= CAP) rank = CAP - 1; const int slot = e * CAP + rank;
                    ROWSTOK[slot] = row0 + tid; GATEW[slot] = selp[tid * 4 + k]; RSTDW[slot] = rstd_l[tid]; TOKSLOT[(row0 + tid) * 4 + k] = slot; }
            }
            __syncthreads();
        }
    }
    SEAM(5);

    if (IN(6))
    {
        build_moe_tables(tab, gcount);
        pg8::MoeProb<16, true> P{H8, WgT, WuT, ROWSTOK, DM, G, vcu, __builtin_amdgcn_readfirstlane(tab[31]), tab, 0};
        pg8::EpiSwiglu E{Act, args.in[I_BGATE], args.in[I_BUP], RSTDW, lds + LDS_EPI};
        pg8::gemm_phase(lds, P, E);
    }
    SEAM(6);

    if (IN(7))
    {
        build_moe_tables(tab, gcount);
        pg8::MoeProb<8, false> P{Act, WdT, WdT, ROWSTOK, DFF, G, vcu, __builtin_amdgcn_readfirstlane(tab[128 + 31]), tab, 128};
        pg8::EpiDown E{Yb, args.in[I_BDOWN], GATEW, lds + LDS_EPI};
        pg8::gemm_phase(lds, P, E);
    }
    SEAM(7);

    if (IN(8)) {
        build_moe_tables(tab, gcount);
        const float* gfin = args.in[I_NFING];
        for (int m = gw; m < T; m += NGW) {
            const unsigned char* yr[TOPK];
#pragma unroll
            for (int k = 0; k < TOPK; ++k) { const int slot = __builtin_amdgcn_readfirstlane(TOKSLOT[m * 4 + k]); const int e = slot >> 14, rank = slot & (CAP - 1); yr[k] = Yb + ((size_t)tab[64 + e] * 256 + rank) * DM; }
            const u32x2* hr = (const u32x2*)(Hb + (size_t)m * DM) + lane; f32x4* xr = (f32x4*)(args.out + (size_t)m * DM) + lane; const f32x4* gr = (const f32x4*)gfin + lane;
            f32x4 v[8]; float s = 0.f; constexpr float IY = 1.0f / pg8::Y_SCALE;
#pragma unroll
            for (int j = 0; j < 8; ++j) { const u32x2 hw = hr[64 * j]; v[j] = (f32x4){bf_lo(hw.x), bf_hi(hw.x), bf_lo(hw.y), bf_hi(hw.y)}; f32x4 ys = {0.f, 0.f, 0.f, 0.f};
#pragma unroll
                for (int k = 0; k < TOPK; ++k) { const unsigned y = *((const unsigned*)yr[k] + lane + 64 * j); const f32x2 lo = __builtin_amdgcn_cvt_pk_f32_fp8((int)y, false), hi2 = __builtin_amdgcn_cvt_pk_f32_fp8((int)y, true);
                    ys.x += lo.x; ys.y += lo.y; ys.z += hi2.x; ys.w += hi2.y; }
                v[j] = v[j] + ys * IY;
                s += (v[j].x * v[j].x + v[j].y * v[j].y) + (v[j].z * v[j].z + v[j].w * v[j].w); }
            const float rstd = 1.0f / sqrtf(wave_sum(s) * (1.f / DM) + EPS);
#pragma unroll
            for (int j = 0; j < 8; ++j) { const f32x4 gg = gr[64 * j]; xr[64 * j] = (f32x4){v[j].x * rstd * gg.x, v[j].y * rstd * gg.y, v[j].z * rstd * gg.z, v[j].w * rstd * gg.w}; }
        }
    }
#undef IN
#undef SEAM
}

extern "C" void kernel_launch(void* const* d_in, const int* in_sizes, int n_in, void* d_out, int out_size, void* d_ws, size_t ws_size, hipStream_t stream) {
    static int grid = 0;
    if (grid == 0) {
        if (n_in != 22 || out_size != T * DM || ws_size < WS_END) { fprintf(stderr, "kernel_launch: unexpected shapes (n_in %d out %d ws %zu need %zu)\n", n_in, out_size, ws_size, (size_t)WS_END); grid = -1; return; }
        int dev = 0, cus = 0, per_cu = 0;
        if (hipGetDevice(&dev) != hipSuccess || hipDeviceGetAttribute(&cus, hipDeviceAttributeMultiprocessorCount, dev) != hipSuccess) { grid = -1; return; }
        if (hipFuncSetAttribute((const void*)fwd, hipFuncAttributeMaxDynamicSharedMemorySize, LDS_BYTES) != hipSuccess) { fprintf(stderr, "kernel_launch: hipFuncSetAttribute failed\n"); grid = -1; return; }
        if (hipOccupancyMaxActiveBlocksPerMultiprocessor(&per_cu, (const void*)fwd, NTHR, LDS_BYTES) != hipSuccess || per_cu < 1) fprintf(stderr, "kernel_launch: occupancy query reports %d\n", per_cu);
        (void)hipGetLastError();
        grid = cus;
    }
    if (grid < 0) return;
    if (hipMemsetAsync((char*)d_ws + WS_CTL, 0, CTL_ZERO_BYTES, stream) != hipSuccess) return;
    Args a{};
    for (int i = 0; i < 22; ++i) a.in[i] = (const float*)d_in[i];
    a.out = (float*)d_out; a.ws = (unsigned char*)d_ws;
    constexpr int NPH = 9;
    if (MK_N_LAUNCHES == 1) { a.ph_lo = 0; a.ph_hi = NPH; hipLaunchKernelGGL(fwd, dim3(grid), dim3(NTHR), LDS_BYTES, stream, a); }
    else for (int p = 0; p < NPH; ++p) { a.ph_lo = p; a.ph_hi = p + 1; hipLaunchKernelGGL(fwd, dim3(grid), dim3(NTHR), LDS_BYTES, stream, a); }
    const hipError_t le = hipPeekAtLastError();
    if (le != hipSuccess) fprintf(stderr, "kernel_launch: launch failed: %s\n", hipGetErrorName(le));
}
```

```cpp
#include <hip/hip_runtime.h>
#include <cstdio>
#include <cstdint>

#ifndef PG8_ALIGN
#define PG8_ALIGN true
#endif
#ifndef MK_N_LAUNCHES
#define MK_N_LAUNCHES 1
#endif

#define LAS __attribute__((address_space(3)))
#define GAS __attribute__((address_space(1)))
typedef unsigned short bf16_t;
typedef short bf16x8 __attribute__((ext_vector_type(8)));
typedef short s16x4 __attribute__((ext_vector_type(4)));
typedef float f32x2 __attribute__((ext_vector_type(2)));
typedef float f32x4 __attribute__((ext_vector_type(4)));
typedef float f32x16 __attribute__((ext_vector_type(16)));
typedef unsigned u32x2 __attribute__((ext_vector_type(2)));
typedef unsigned u32x4 __attribute__((ext_vector_type(4)));

constexpr int T = 16384, DM = 2048, NB = 8, SEQ = 2048, NMEM = 256, INW = 10240, NE = 32, TOPK = 4, CAP = 16384, DFF = 2048;
constexpr int MEMR = NB * NMEM;
constexpr int C_POOL = 0, C_QSB = 512, C_KSB = 1536, C_VSB = 2560, C_QXA = 3584, C_GATE = 4096;
constexpr float EPS = 1e-5f;
constexpr int NROWS_MAX = 73728;

constexpr size_t MiB = 1u << 20;
constexpr size_t WS_CTL = 0, CTL_ZERO_BYTES = 1 * MiB;
constexpr size_t WS_WIN = 1 * MiB;
constexpr size_t WS_WING8 = WS_WIN + (size_t)C_GATE * DM * 2;
constexpr size_t WS_WMIX = WS_WIN + (size_t)INW * DM * 2;
constexpr size_t WS_WKV = WS_WMIX + (size_t)DM * DM * 2;
constexpr size_t WS_WOUT = WS_WKV + (size_t)1024 * DM * 2;
constexpr size_t WS_WG = WS_WOUT + (size_t)DM * DM * 2;
constexpr size_t WS_WU = WS_WG + (size_t)NE * DM * DFF * 2;
constexpr size_t WS_WD = WS_WU + (size_t)NE * DM * DFF * 2;
constexpr size_t WS_P = WS_WD + (size_t)NE * DM * DFF * 2;
constexpr size_t WS_ACT = WS_P;
constexpr size_t WS_XN = WS_P + (size_t)T * INW * 2;
constexpr size_t WS_MEMN = WS_XN + (size_t)T * DM * 2;
constexpr size_t WS_KVXA = WS_MEMN + (size_t)MEMR * DM * 2;
constexpr size_t WS_MIX = WS_KVXA + (size_t)MEMR * 1024 * 2;
constexpr size_t WS_MERGED = WS_MIX + (size_t)T * DM * 2;
constexpr size_t WS_HN = WS_MERGED + (size_t)T * DM * 2;
constexpr size_t WS_ROWSTOK = WS_HN + (size_t)T * DM * 2;
constexpr size_t WS_GATEW = WS_ROWSTOK + (size_t)NE * CAP * 4;
constexpr size_t WS_TOKSLOT = WS_GATEW + (size_t)NE * CAP * 4;
constexpr size_t WS_WRT = WS_TOKSLOT + 512 * 1024;
constexpr size_t WS_XN8 = WS_TOKSLOT + 1 * MiB;
constexpr size_t WS_Y = WS_XN8 + (size_t)T * DM;
constexpr size_t WS_GATE8 = WS_Y + (size_t)NROWS_MAX * DM;
constexpr size_t WS_RSTDW = WS_Y + (size_t)NROWS_MAX * DM * 2;
constexpr size_t WS_END = WS_RSTDW + (size_t)NE * CAP * 4;
static_assert(WS_WING8 + (size_t)(INW - C_GATE) * DM <= WS_WMIX, "fp8 gate weights fit behind the bf16 part");
static_assert(WS_END <= (size_t)2048 * MiB, "workspace map exceeds 2 GiB");
static_assert(WS_GATE8 + (size_t)T * (INW - C_GATE) <= WS_RSTDW, "u8 gate tiles fit behind Y");
static_assert((size_t)NROWS_MAX * DM * 2 <= (size_t)T * INW * 2, "ACT overlays P");
constexpr int CW_BAR = 4096;
constexpr int CW_GCOUNT = 16384;
constexpr int CW_PARTA = 16384 + 64;

constexpr int RING_BYTES = 131072;
constexpr int LDS_TAB = RING_BYTES;
constexpr int LDS_MISC = RING_BYTES + 1024;
constexpr int LDS_EPI = RING_BYTES + 2048;
constexpr int LDS_BYTES = 147456;
constexpr int NWAVES = 8, NTHR = 512;

__device__ __forceinline__ unsigned cvt_pk_bf16(float lo, float hi) { unsigned r; asm volatile("v_cvt_pk_bf16_f32 %0, %1, %2" : "=v"(r) : "v"(lo), "v"(hi)); return r; }
__device__ __forceinline__ float bf_lo(unsigned w) { return __uint_as_float(w << 16); }
__device__ __forceinline__ float bf_hi(unsigned w) { return __uint_as_float(w & 0xffff0000u); }
__device__ __forceinline__ float wave_sum(float v) {
#pragma unroll
    for (int o = 1; o < 64; o <<= 1) v += __shfl_xor(v, o);
    return v;
}
__device__ __forceinline__ float fast_sigmoid(float x) { return __builtin_amdgcn_rcpf(1.0f + __builtin_amdgcn_exp2f(-1.4426950408889634f * x)); }
#define LDS_WAIT() asm volatile("s_waitcnt lgkmcnt(0)" ::: "memory")
#define VM_WAIT() asm volatile("s_waitcnt vmcnt(0)" ::: "memory")

namespace pg8 {
constexpr int BM = 256, BK = 64, HALF = 128, HTB = HALF * BK * 2, STAGE_BYTES = 8 * HTB, NXCD = 8, WGM = 8;
__host__ __device__ __forceinline__ int lds_byte(int r, int c) { return r * 128 + ((((c >> 3) ^ (r >> 1)) & 7) << 4) + (c & 7) * 2; }
__host__ __device__ __forceinline__ void stage_rc(int b, int& R, int& C) { R = b >> 7; const int p = (b >> 4) & 7; C = ((p ^ (R >> 1)) & 7) * 8; }
__host__ __device__ __forceinline__ int perm32(int rho) { const int n = rho >> 4, i = rho & 15; return 8 * (i >> 2) + 4 * n + (i & 3); }

struct Unit { int pm, pn, e, mt, cnt; };
typedef int v4i_t __attribute__((ext_vector_type(4)));
typedef int v8i_t __attribute__((ext_vector_type(8)));
__device__ __forceinline__ bf16x8 lo8(v8i_t v) { return __builtin_bit_cast(bf16x8, (v4i_t)__builtin_shufflevector(v, v, 0, 1, 2, 3)); }
__device__ __forceinline__ bf16x8 hi8(v8i_t v) { return __builtin_bit_cast(bf16x8, (v4i_t)__builtin_shufflevector(v, v, 4, 5, 6, 7)); }
__device__ __forceinline__ v8i_t cat8(bf16x8 a, bf16x8 b) { const v4i_t x = __builtin_bit_cast(v4i_t, a), y = __builtin_bit_cast(v4i_t, b); return __builtin_shufflevector(x, y, 0, 1, 2, 3, 4, 5, 6, 7); }

template <bool FP8_> struct DenseProbT {
    static constexpr bool GATHER = false, FP8 = FP8_;
    const void* A; const void* Bt; int M, N, Kb;
    int nM, nN, nwg, G, c;
    __device__ __forceinline__ void init(const void* A_, const void* Bt_, int M_, int N_, int K_, int G_, int c_) { A = A_; Bt = Bt_; M = M_; N = N_; Kb = FP8_ ? K_ : K_ * 2; nM = M / BM; nN = N / BM; nwg = nM * nN; G = G_; c = c_; }
    __device__ __forceinline__ bool next(int i, Unit& u) const {
        const long L = (long)i * G + c; if (L >= nwg) return false;
        int wgid = (int)L; { const int q = nwg / NXCD, r = nwg % NXCD, xcd = wgid % NXCD, off = wgid / NXCD; wgid = (xcd < r ? xcd * (q + 1) : r * (q + 1) + (xcd - r) * q) + off; }
        const int nig = WGM * nN, gid = wgid / nig, fm = gid * WGM, gsz = (nM - fm) < WGM ? (nM - fm) : WGM;
        u.pm = fm + ((wgid % nig) % gsz); u.pn = (wgid % nig) / gsz; u.e = 0; u.mt = 0; u.cnt = 0; return true;
    }
    __device__ __forceinline__ const char* a_ptr(const Unit& u) const { return (const char*)A + (size_t)u.pm * 256 * Kb; }
    __device__ __forceinline__ const char* a_base() const { return (const char*)A; }
    __device__ __forceinline__ void a_gather(const Unit&, unsigned (&)[2][2]) const {}
    __device__ __forceinline__ const char* b_ptr(const Unit& u, int h) const { return (const char*)Bt + ((size_t)u.pn * 256 + (size_t)h * 128) * Kb; }
};
typedef DenseProbT<false> DenseProb;
typedef DenseProbT<true> DenseProb8;

template <int NPN  , bool GATHER_>
struct MoeProb {
    static constexpr bool GATHER = GATHER_, FP8 = true;
    const unsigned char* A; const unsigned char* B0; const unsigned char* B1; const int* rows_tok; int Kb; int G, c, total; const LAS int* tab; int uoff;
    __device__ __forceinline__ bool next(int i, Unit& u) const {
        const int L = i * G + c; if (L >= total) return false;
        const int lane = threadIdx.x & 63;
        const int te = (lane < NE) ? tab[uoff + lane] : 0x7fffffff;
        const unsigned long long mk = __ballot(L >= te);
        const int e = __builtin_amdgcn_readfirstlane(__popcll(mk));
        const int start = __builtin_amdgcn_readfirstlane(e ? tab[uoff + e - 1] : 0), ntm = __builtin_amdgcn_readfirstlane(tab[32 + e]);
        const int rem = L - start, per_ng = ntm * 4, ng = rem / per_ng, r2 = rem - ng * per_ng, mt = r2 >> 2, nn = r2 & 3;
        u.e = e; u.mt = mt; u.pn = ng * 4 + nn; u.pm = __builtin_amdgcn_readfirstlane(tab[64 + e]) + mt; u.cnt = __builtin_amdgcn_readfirstlane(tab[96 + e]); return true;
    }
    __device__ __forceinline__ const char* a_ptr(const Unit& u) const { return (const char*)A + (size_t)u.pm * 256 * Kb; }
    __device__ __forceinline__ const char* a_base() const { return (const char*)A; }
    __device__ __forceinline__ void a_gather(const Unit& u, unsigned (&off)[2][2]) const {
#pragma unroll
        for (int i = 0; i < 2; ++i) { int R, C; stage_rc((int)threadIdx.x * 16 + i * 8192, R, C);
#pragma unroll
            for (int h = 0; h < 2; ++h) { const int lr = u.mt * 256 + h * 128 + R; int tok = rows_tok[u.e * CAP + lr]; tok = (lr < u.cnt) ? tok : 0; off[h][i] = (unsigned)tok * (unsigned)Kb + (unsigned)(C * 2); } }
    }
    __device__ __forceinline__ const char* b_ptr(const Unit& u, int h) const {
        if (NPN == 16) return (const char*)(h ? B1 : B0) + ((size_t)u.e * DFF + (size_t)u.pn * 128) * Kb;
        return (const char*)B0 + ((size_t)u.e * DM + (size_t)u.pn * 256 + (size_t)h * 128) * Kb;
    }
};

__device__ __forceinline__ void glds16(const char* base, unsigned voff, unsigned lds_dst) {
    asm volatile("s_mov_b32 m0, %2\n\ts_nop 0\n\tglobal_load_lds_dwordx4 %0, %1" :: "v"(voff), "s"(base), "s"(lds_dst) : "memory");
}
template <class Prob, class Epi, bool ALIGN_EPI = PG8_ALIGN>
__device__ __forceinline__ void gemm_phase(LAS unsigned char* lds, const Prob& P, const Epi& E) {
    constexpr bool GATHER = Prob::GATHER;
    const int tid = threadIdx.x, wid = __builtin_amdgcn_readfirstlane(tid >> 6), lane = tid & 63, wr = wid >> 2, wc = wid & 3, fr = lane & 15, fq = lane >> 4;
    constexpr bool FP8 = Prob::FP8;
    const int Kb = P.Kb, nt = Kb / (BK * 2);
    unsigned voffA[2], voffB[2];
#pragma unroll
    for (int i = 0; i < 2; ++i) { int R, C; stage_rc(tid * 16 + i * 8192, R, C); const int Rb = Epi::PERM ? ((R & ~31) + perm32(R & 31)) : R;
        voffA[i] = (unsigned)(R * Kb + C * 2); voffB[i] = (unsigned)(Rb * Kb + C * 2); }
    const size_t kstep = (size_t)(BK * 2);
    const size_t hstep = (size_t)HALF * Kb;
    const unsigned ldsw = (unsigned)wid * 1024u;
    const unsigned lds_u = (unsigned)(size_t)lds;
    const int aoff = lds_byte(wr * 64 + fr, fq * 8), boff = lds_byte(wc * 32 + fr, fq * 8);
    const int aoff1 = aoff ^ 64, boff1 = boff ^ 64;
#define PG8_SA(b, h) (((b) * 2 + (h)) * HTB)
#define PG8_SB(b, h) ((4 + (b) * 2 + (h)) * HTB)
#define PG8_STAGE2(bufoff, p, o0, o1) do { glds16((const char*)(p), (o0), lds_u + (unsigned)(bufoff) + ldsw); glds16((const char*)(p), (o1), lds_u + (unsigned)(bufoff) + ldsw + 8192u); } while (0)
#define PG8_STAGE_A(bufoff, h, nx, tt) do { if constexpr (GATHER) { const char* p_ = Ab + (size_t)(tt) * kstep; PG8_STAGE2(bufoff, p_, ((nx) ? noff[h][0] : coff[h][0]), ((nx) ? noff[h][1] : coff[h][1])); } \
        else { const char* p_ = ((nx) ? nA : cA) + (size_t)(h) * hstep + (size_t)(tt) * kstep; PG8_STAGE2(bufoff, p_, voffA[0], voffA[1]); } } while (0)
#define PG8_STAGE_B(bufoff, h, nx, tt) do { const char* p_ = ((nx) ? nB[h] : cB[h]) + (size_t)(tt) * kstep; PG8_STAGE2(bufoff, p_, voffB[0], voffB[1]); } while (0)
#define PG8_LDA(dst, b, h) do { _Pragma("unroll") for (int m = 0; m < 4; ++m) dst[m] = cat8(*(const LAS bf16x8*)(lds + PG8_SA(b, h) + aoff + m * 2048), *(const LAS bf16x8*)(lds + PG8_SA(b, h) + aoff1 + m * 2048)); } while (0)
#define PG8_LDB(dst, b, h) do { _Pragma("unroll") for (int n = 0; n < 2; ++n) dst[n] = cat8(*(const LAS bf16x8*)(lds + PG8_SB(b, h) + boff + n * 2048), *(const LAS bf16x8*)(lds + PG8_SB(b, h) + boff1 + n * 2048)); } while (0)
#define PG8_MMA(ai, bj, At, Bt) do { __builtin_amdgcn_s_setprio(1); _Pragma("unroll") for (int m = 0; m < 4; ++m) _Pragma("unroll") for (int n = 0; n < 2; ++n) { \
        if constexpr (FP8) asm volatile("v_mfma_scale_f32_16x16x128_f8f6f4 %0, %1, %2, %0, %3, %3 op_sel_hi:[0,0,0]" : "+v"(acc[ai][bj][m][n]) : "v"(Bt[n]), "v"(At[m]), "v"(fp8_one)); \
        else { acc[ai][bj][m][n] = __builtin_amdgcn_mfma_f32_16x16x32_bf16(lo8(Bt[n]), lo8(At[m]), acc[ai][bj][m][n], 0, 0, 0); \
               acc[ai][bj][m][n] = __builtin_amdgcn_mfma_f32_16x16x32_bf16(hi8(Bt[n]), hi8(At[m]), acc[ai][bj][m][n], 0, 0, 0); } } \
        __builtin_amdgcn_s_setprio(0); } while (0)
#define PG8_WAIT_V(n) asm volatile("s_waitcnt vmcnt(" #n ")" ::: "memory")
#define PG8_WAIT_L(n) asm volatile("s_waitcnt lgkmcnt(" #n ")" ::: "memory")
#define PG8_BAR __builtin_amdgcn_s_barrier()
#define PG8_SCHED __builtin_amdgcn_sched_barrier(0)
    Unit cur, nxt; int ui = 0;
    if (!P.next(0, cur)) return;
    f32x4 acc[2][2][4][2];
#pragma unroll
    for (int a = 0; a < 2; ++a)
#pragma unroll
        for (int b = 0; b < 2; ++b)
#pragma unroll
            for (int m = 0; m < 4; ++m)
#pragma unroll
                for (int n = 0; n < 2; ++n) acc[a][b][m][n] = (f32x4){0.f, 0.f, 0.f, 0.f};
    v8i_t At[4], B0[2], B1[2];
    const int fp8_one = 0x7f7f7f7f;
    const char* Ab = P.a_base();
    const char* cA = nullptr; const char* nA = nullptr; const char* cB[2]; const char* nB[2];
    unsigned coff[2][2] = {{0u, 0u}, {0u, 0u}}, noff[2][2] = {{0u, 0u}, {0u, 0u}};
    if constexpr (GATHER) P.a_gather(cur, coff); else cA = P.a_ptr(cur);
    cB[0] = P.b_ptr(cur, 0); cB[1] = P.b_ptr(cur, 1);
    PG8_STAGE_B(PG8_SB(0, 0), 0, false, 0); PG8_STAGE_B(PG8_SB(0, 1), 1, false, 0); PG8_STAGE_A(PG8_SA(0, 0), 0, false, 0); PG8_STAGE_A(PG8_SA(0, 1), 1, false, 0);
    if (wr == 1) PG8_BAR;
    PG8_WAIT_V(2); PG8_BAR;
    PG8_STAGE_B(PG8_SB(1, 0), 0, false, 1); PG8_STAGE_B(PG8_SB(1, 1), 1, false, 1);
    PG8_WAIT_V(6); PG8_BAR;
    for (;;) {
        const bool has_next = P.next(ui + 1, nxt);
        if (has_next) { if constexpr (GATHER) P.a_gather(nxt, noff); else nA = P.a_ptr(nxt); nB[0] = P.b_ptr(nxt, 0); nB[1] = P.b_ptr(nxt, 1); }
        else { if constexpr (GATHER) { noff[0][0] = coff[0][0]; noff[0][1] = coff[0][1]; noff[1][0] = coff[1][0]; noff[1][1] = coff[1][1]; } else nA = cA; nB[0] = cB[0]; nB[1] = cB[1]; }
        for (int t = 0; t < nt; t += 2) {
            if constexpr (Epi::HAS_MID) { if (t == Epi::T1 || t == Epi::T2) E.mid(acc, cur, t, wr, wc, fr, fq); }
            const bool last = (t == nt - 2);
            if constexpr (Epi::HAS_PRE) { if (last) E.pre(cur, wid, lane); }
            const int t2 = last ? 0 : t + 2, t3 = t2 + 1;
            PG8_LDB(B0, 0, 0); PG8_LDB(B1, 0, 1); PG8_SCHED; PG8_LDA(At, 0, 0); PG8_STAGE_A(PG8_SA(1, 0), 0, false, t + 1); PG8_STAGE_A(PG8_SA(1, 1), 1, false, t + 1);
            PG8_WAIT_V(8); PG8_WAIT_L(0); PG8_BAR; PG8_MMA(0, 0, At, B0); PG8_MMA(0, 1, At, B1); PG8_BAR; PG8_SCHED;
            PG8_LDA(At, 0, 1); PG8_STAGE_B(PG8_SB(0, 0), 0, last, t2); PG8_STAGE_B(PG8_SB(0, 1), 1, last, t2);
            PG8_WAIT_V(6); PG8_WAIT_L(0); PG8_BAR; PG8_MMA(1, 0, At, B0); PG8_MMA(1, 1, At, B1); PG8_BAR; PG8_SCHED;
            PG8_LDB(B0, 1, 0); PG8_LDB(B1, 1, 1); PG8_SCHED; PG8_LDA(At, 1, 0); PG8_STAGE_A(PG8_SA(0, 0), 0, last, t2); PG8_STAGE_A(PG8_SA(0, 1), 1, last, t2);
            PG8_WAIT_V(8); PG8_WAIT_L(0); PG8_BAR; PG8_MMA(0, 0, At, B0); PG8_MMA(0, 1, At, B1); PG8_BAR; PG8_SCHED;
            PG8_LDA(At, 1, 1); PG8_STAGE_B(PG8_SB(1, 0), 0, last, t3); PG8_STAGE_B(PG8_SB(1, 1), 1, last, t3);
            PG8_WAIT_V(6); PG8_WAIT_L(0); PG8_BAR; PG8_MMA(1, 0, At, B0); PG8_MMA(1, 1, At, B1); PG8_BAR; PG8_SCHED;
        }
        if constexpr (ALIGN_EPI) { if (wr == 0) PG8_BAR; }
        if constexpr (FP8) asm volatile("s_nop 15\n\ts_nop 15" ::: "memory");
        E(acc, cur, wr, wc, fr, fq);
        if (!has_next) break;
#pragma unroll
        for (int a = 0; a < 2; ++a)
#pragma unroll
            for (int b = 0; b < 2; ++b)
#pragma unroll
                for (int m = 0; m < 4; ++m)
#pragma unroll
                    for (int n = 0; n < 2; ++n) acc[a][b][m][n] = (f32x4){0.f, 0.f, 0.f, 0.f};
        cur = nxt; cB[0] = nB[0]; cB[1] = nB[1]; ++ui;
        if constexpr (GATHER) { coff[0][0] = noff[0][0]; coff[0][1] = noff[0][1]; coff[1][0] = noff[1][0]; coff[1][1] = noff[1][1]; } else cA = nA;
        if constexpr (ALIGN_EPI) { if (wr == 1) PG8_BAR; }
    }
    PG8_WAIT_V(0);
    if constexpr (!ALIGN_EPI) { if (wr == 0) PG8_BAR; }
    PG8_BAR;
#undef PG8_SA
#undef PG8_SB
#undef PG8_STAGE2
#undef PG8_STAGE_A
#undef PG8_STAGE_B
#undef PG8_LDA
#undef PG8_LDB
#undef PG8_MMA
#undef PG8_WAIT_V
#undef PG8_WAIT_L
#undef PG8_BAR
#undef PG8_SCHED
}

constexpr float W_SCALE = 64.f, ACT_SCALE = 4.f;
__device__ __forceinline__ float clamp_fp8(float x) { return __builtin_amdgcn_fmed3f(x, -448.0f, 448.0f); }
__device__ __forceinline__ unsigned pk4_fp8(float a, float b, float c, float d) { int w = 0; w = __builtin_amdgcn_cvt_pk_fp8_f32(clamp_fp8(a), clamp_fp8(b), w, false); w = __builtin_amdgcn_cvt_pk_fp8_f32(clamp_fp8(c), clamp_fp8(d), w, true); return (unsigned)w; }
constexpr float M_SCALE = 16.f;
struct EpiStoreBf16 {
    static constexpr bool PERM = true, HAS_MID = false, HAS_PRE = false;
    bf16_t* O; int ldc; int sig_from; float scale;
    __device__ __forceinline__ void operator()(const f32x4 (&acc)[2][2][4][2], const Unit& u, int wr, int wc, int fr, int fq) const {
        const int row0 = u.pm * BM + wr * 64 + fr, col0 = u.pn * BM + wc * 32 + 8 * fq;
        const bool sg = u.pn >= sig_from;
#pragma unroll
        for (int ai = 0; ai < 2; ++ai)
#pragma unroll
            for (int m = 0; m < 4; ++m) { bf16_t* rowp = O + (size_t)(row0 + ai * HALF + m * 16) * ldc + col0;
#pragma unroll
                for (int bj = 0; bj < 2; ++bj) { f32x4 v0 = acc[ai][bj][m][0] * scale, v1 = acc[ai][bj][m][1] * scale;
                    if (sg) {
#pragma unroll
                        for (int j = 0; j < 4; ++j) { v0[j] = fast_sigmoid(v0[j]); v1[j] = fast_sigmoid(v1[j]); } }
                    u32x4 w; w.x = cvt_pk_bf16(v0[0], v0[1]); w.y = cvt_pk_bf16(v0[2], v0[3]); w.z = cvt_pk_bf16(v1[0], v1[1]); w.w = cvt_pk_bf16(v1[2], v1[3]);
                    *(u32x4*)(rowp + bj * HALF) = w; } }
    }
};
__device__ __forceinline__ unsigned pk4_u8(f32x4 v) { unsigned w = 0;
    w = __builtin_amdgcn_cvt_pk_u8_f32(v[0], 0, w); w = __builtin_amdgcn_cvt_pk_u8_f32(v[1], 1, w); w = __builtin_amdgcn_cvt_pk_u8_f32(v[2], 2, w); w = __builtin_amdgcn_cvt_pk_u8_f32(v[3], 3, w); return w; }
constexpr int GATE_TILES_N = (INW - C_GATE) / BM;
__device__ __forceinline__ size_t gate_tile_off(int pm, int tn, int wr, int wc, int fr, int fq) { return ((size_t)(pm * GATE_TILES_N + tn) << 16) + (size_t)(((wr * 4 + wc) * 64 + fq * 16 + fr) * 8); }
struct EpiGateU8 {
    static constexpr bool PERM = true, HAS_MID = false, HAS_PRE = false;
    unsigned char* O; float scale;
    __device__ __forceinline__ void operator()(const f32x4 (&acc)[2][2][4][2], const Unit& u, int wr, int wc, int fr, int fq) const {
        unsigned char* base = O + gate_tile_off(u.pm, u.pn, wr, wc, fr, fq);
#pragma unroll
        for (int ai = 0; ai < 2; ++ai)
#pragma unroll
            for (int m = 0; m < 4; ++m)
#pragma unroll
                for (int bj = 0; bj < 2; ++bj) { f32x4 v0 = acc[ai][bj][m][0] * scale, v1 = acc[ai][bj][m][1] * scale;
#pragma unroll
                    for (int j = 0; j < 4; ++j) { v0[j] = fmaxf(__builtin_rintf(255.0f * fast_sigmoid(v0[j])), 1.0f); v1[j] = fmaxf(__builtin_rintf(255.0f * fast_sigmoid(v1[j])), 1.0f); }
                    u32x2 w; w.x = pk4_u8(v0); w.y = pk4_u8(v1);
                    *(u32x2*)(base + ((ai * 4 + m) * 2 + bj) * 4096) = w; }
    }
};
struct EpiMix {
    static constexpr bool PERM = true, HAS_MID = true, HAS_PRE = false; static constexpr int T1 = 8, T2 = 24;
    unsigned char* M8; const unsigned char* G8;
    static __device__ __forceinline__ float ub(unsigned w, int j) { return (float)((w >> (8 * j)) & 0xffu); }
    __device__ __forceinline__ void mid(f32x4 (&acc)[2][2][4][2], const Unit& u, int t, int wr, int wc, int fr, int fq) const {
        const int gi = (t == T1) ? 0 : 1;
        const unsigned char* pa = G8 + gate_tile_off(u.pm, gi * 8 + u.pn, wr, wc, fr, fq); const unsigned char* pb = pa + ((size_t)8 << 16);
#pragma unroll
        for (int ai = 0; ai < 2; ++ai) {
            u32x2 ga[4][2], gb[4][2];
#pragma unroll
            for (int m = 0; m < 4; ++m)
#pragma unroll
                for (int bj = 0; bj < 2; ++bj) { ga[m][bj] = *(const u32x2*)(pa + ((ai * 4 + m) * 2 + bj) * 4096); gb[m][bj] = *(const u32x2*)(pb + ((ai * 4 + m) * 2 + bj) * 4096); }
#pragma unroll
            for (int m = 0; m < 4; ++m)
#pragma unroll
                for (int bj = 0; bj < 2; ++bj) { const u32x2 a = ga[m][bj], b = gb[m][bj]; f32x4& v0 = acc[ai][bj][m][0]; f32x4& v1 = acc[ai][bj][m][1];
#pragma unroll
                    for (int j = 0; j < 4; ++j) { v0[j] *= ub(a.x, j) * __builtin_amdgcn_rcpf(ub(b.x, j)); v1[j] *= ub(a.y, j) * __builtin_amdgcn_rcpf(ub(b.y, j)); } }
            asm volatile("" ::: "memory"); }
    }
    __device__ __forceinline__ void operator()(const f32x4 (&acc)[2][2][4][2], const Unit& u, int wr, int wc, int fr, int fq) const {
        const int row0 = u.pm * BM + wr * 64 + fr, col0 = u.pn * BM + wc * 32 + 8 * fq;
        const unsigned char* pg = G8 + gate_tile_off(u.pm, 16 + u.pn, wr, wc, fr, fq);
        constexpr float IQ = M_SCALE / 255.0f;
#pragma unroll
        for (int ai = 0; ai < 2; ++ai) {
            u32x2 gq[4][2];
#pragma unroll
            for (int m = 0; m < 4; ++m)
#pragma unroll
                for (int bj = 0; bj < 2; ++bj) gq[m][bj] = *(const u32x2*)(pg + ((ai * 4 + m) * 2 + bj) * 4096);
#pragma unroll
            for (int m = 0; m < 4; ++m) { const size_t row = (size_t)(row0 + ai * HALF + m * 16);
#pragma unroll
                for (int bj = 0; bj < 2; ++bj) { const u32x2 gg = gq[m][bj]; f32x4 v0 = acc[ai][bj][m][0], v1 = acc[ai][bj][m][1];
#pragma unroll
                    for (int j = 0; j < 4; ++j) { v0[j] *= ub(gg.x, j) * IQ; v1[j] *= ub(gg.y, j) * IQ; }
                    u32x2 w; w.x = pk4_fp8(v0[0], v0[1], v0[2], v0[3]); w.y = pk4_fp8(v1[0], v1[1], v1[2], v1[3]);
                    *(u32x2*)(M8 + row * DM + col0 + bj * HALF) = w; } }
            asm volatile("" ::: "memory"); }
    }
};
struct EpiResid8 {
    static constexpr bool PERM = true, HAS_MID = false, HAS_PRE = false;
    const float* X; bf16_t* Hb; unsigned char* H8; float scale;
    __device__ __forceinline__ void operator()(const f32x4 (&acc)[2][2][4][2], const Unit& u, int wr, int wc, int fr, int fq) const {
        const int row0 = u.pm * BM + wr * 64 + fr, col0 = u.pn * BM + wc * 32 + 8 * fq;
#pragma unroll
        for (int ai = 0; ai < 2; ++ai) {
            f32x4 xq[4][2][2];
#pragma unroll
            for (int m = 0; m < 4; ++m) { const size_t off = (size_t)(row0 + ai * HALF + m * 16) * DM + col0;
#pragma unroll
                for (int bj = 0; bj < 2; ++bj) { xq[m][bj][0] = *(const f32x4*)(X + off + bj * HALF); xq[m][bj][1] = *(const f32x4*)(X + off + bj * HALF + 4); } }
#pragma unroll
            for (int m = 0; m < 4; ++m) { const size_t off = (size_t)(row0 + ai * HALF + m * 16) * DM + col0;
#pragma unroll
                for (int bj = 0; bj < 2; ++bj) { const f32x4 v0 = xq[m][bj][0] + acc[ai][bj][m][0] * scale, v1 = xq[m][bj][1] + acc[ai][bj][m][1] * scale;
                    u32x4 w; w.x = cvt_pk_bf16(v0[0], v0[1]); w.y = cvt_pk_bf16(v0[2], v0[3]); w.z = cvt_pk_bf16(v1[0], v1[1]); w.w = cvt_pk_bf16(v1[2], v1[3]);
                    *(u32x4*)(Hb + off + bj * HALF) = w;
                    u32x2 q; q.x = pk4_fp8(bf_lo(w.x), bf_hi(w.x), bf_lo(w.y), bf_hi(w.y)); q.y = pk4_fp8(bf_lo(w.z), bf_hi(w.z), bf_lo(w.w), bf_hi(w.w));
                    *(u32x2*)(H8 + off + bj * HALF) = q; } }
            asm volatile("" ::: "memory"); }
    }
};
struct EpiSwiglu {
    static constexpr bool PERM = true, HAS_MID = false, HAS_PRE = true;
    unsigned char* Act; const float* bg; const float* bu; const float* rstdw; LAS unsigned char* le;
    __device__ __forceinline__ void pre(const Unit& u, int wid, int lane) const {
        const unsigned dst = (unsigned)(size_t)le;
        if (wid == 0) glds16((const char*)(rstdw + (size_t)u.e * CAP + (size_t)u.mt * BM), (unsigned)lane * 16u, dst);
        else if (wid == 1) { if (lane < 32) glds16((const char*)(bg + (size_t)u.e * DFF + (size_t)u.pn * HALF), (unsigned)lane * 16u, dst + 1024u);
                             else glds16((const char*)(bu + (size_t)u.e * DFF + (size_t)u.pn * HALF), (unsigned)(lane - 32) * 16u, dst + 1024u); }
    }
    __device__ __forceinline__ void operator()(const f32x4 (&acc)[2][2][4][2], const Unit& u, int wr, int wc, int fr, int fq) const {
        const int row0 = u.pm * BM + wr * 64 + fr, col0 = u.pn * HALF + wc * 32 + 8 * fq;
        const LAS float* rsl = (const LAS float*)le + wr * 64 + fr; const LAS unsigned char* bl = le + 1024 + (wc * 32 + 8 * fq) * 4;
        const f32x4 g0 = *(const LAS f32x4*)bl, g1 = *(const LAS f32x4*)(bl + 16), u0 = *(const LAS f32x4*)(bl + 512), u1 = *(const LAS f32x4*)(bl + 528);
        constexpr float IW = 1.0f / W_SCALE;
#pragma unroll
        for (int ai = 0; ai < 2; ++ai)
#pragma unroll
            for (int m = 0; m < 4; ++m) { unsigned char* rowp = Act + (size_t)(row0 + ai * HALF + m * 16) * DFF + col0;
                const float rs = IW * rsl[ai * HALF + m * 16];
                f32x4 a0 = acc[ai][0][m][0] * rs + g0, a1 = acc[ai][0][m][1] * rs + g1, b0 = acc[ai][1][m][0] * rs + u0, b1 = acc[ai][1][m][1] * rs + u1, r0, r1;
#pragma unroll
                for (int j = 0; j < 4; ++j) {
                    float g = fminf(a0[j], 7.0f), up = fminf(fmaxf(b0[j], -7.0f), 7.0f); r0[j] = ACT_SCALE * g * fast_sigmoid(1.702f * g) * (up + 1.0f);
                    g = fminf(a1[j], 7.0f); up = fminf(fmaxf(b1[j], -7.0f), 7.0f); r1[j] = ACT_SCALE * g * fast_sigmoid(1.702f * g) * (up + 1.0f); }
                u32x2 w; w.x = pk4_fp8(r0[0], r0[1], r0[2], r0[3]); w.y = pk4_fp8(r1[0], r1[1], r1[2], r1[3]);
                *(u32x2*)rowp = w; }
    }
};
constexpr float Y_SCALE = 16.f;
struct EpiDown {
    static constexpr bool PERM = true, HAS_MID = false, HAS_PRE = true;
    unsigned char* Y; const float* bd; const float* gatew; LAS unsigned char* le;
    __device__ __forceinline__ void pre(const Unit& u, int wid, int lane) const {
        const unsigned dst = (unsigned)(size_t)le;
        if (wid == 0) glds16((const char*)(gatew + (size_t)u.e * CAP + (size_t)u.mt * BM), (unsigned)lane * 16u, dst);
        else if (wid == 1) glds16((const char*)(bd + (size_t)u.e * DM + (size_t)u.pn * BM), (unsigned)lane * 16u, dst + 1024u);
    }
    __device__ __forceinline__ void operator()(const f32x4 (&acc)[2][2][4][2], const Unit& u, int wr, int wc, int fr, int fq) const {
        const int row0 = u.pm * BM + wr * 64 + fr, col0 = u.pn * BM + wc * 32 + 8 * fq;
        const LAS float* gwl = (const LAS float*)le + wr * 64 + fr; const LAS unsigned char* bl = le + 1024 + (wc * 32 + 8 * fq) * 4;
        constexpr float IS = 1.0f / (W_SCALE * ACT_SCALE);
        f32x4 bv[2][2];
#pragma unroll
        for (int bj = 0; bj < 2; ++bj)
#pragma unroll
            for (int n = 0; n < 2; ++n) bv[bj][n] = *(const LAS f32x4*)(bl + (bj * HALF + 4 * n) * 4);
#pragma unroll
        for (int ai = 0; ai < 2; ++ai)
#pragma unroll
            for (int m = 0; m < 4; ++m) { const float gw = Y_SCALE * gwl[ai * HALF + m * 16];
                unsigned char* rowp = Y + (size_t)(row0 + ai * HALF + m * 16) * DM + col0;
#pragma unroll
                for (int bj = 0; bj < 2; ++bj) { const f32x4 v0 = (acc[ai][bj][m][0] * IS + bv[bj][0]) * gw, v1 = (acc[ai][bj][m][1] * IS + bv[bj][1]) * gw;
                    u32x2 w; w.x = pk4_fp8(v0[0], v0[1], v0[2], v0[3]); w.y = pk4_fp8(v1[0], v1[1], v1[2], v1[3]);
                    *(u32x2*)(rowp + bj * HALF) = w; } }
    }
};
}

namespace att {
constexpr int D = 128, NW = 8, QBLK = 32, KVBLK = 64;
constexpr float SCALE = 0.088388347648318440f;
constexpr float THR = 8.f;
constexpr size_t SHM_V = KVBLK * D * 2, SHM_K = KVBLK * D * 2, SHM_ATTN = 2 * SHM_V + 2 * SHM_K + NW * 64 * 4;
#define KSWZ(row, colB) ((row) * 256 + ((colB) ^ (((row) & 7) << 4)))
#define SBAR() __builtin_amdgcn_sched_barrier(0)
__device__ __forceinline__ int crow(int r, int hi) { return (r & 3) + 8 * (r >> 2) + 4 * hi; }
__device__ __forceinline__ unsigned cvtpk(float lo, float hi) { unsigned r; asm volatile("v_cvt_pk_bf16_f32 %0, %1, %2" : "=v"(r) : "v"(lo), "v"(hi)); return r; }

__device__ __forceinline__ void partialSM(f32x16& p0, f32x16& p1, float& m_reg, float& mn, float& alpha) {
  constexpr float C = SCALE * 1.4426950408889634f;
  float pmax = p0[0]; for (int r = 1; r < 16; ++r) pmax = fmaxf(pmax, p0[r]); for (int r = 0; r < 16; ++r) pmax = fmaxf(pmax, p1[r]);
  { auto rr = __builtin_amdgcn_permlane32_swap(__float_as_uint(pmax), __float_as_uint(pmax), false, false);
    pmax = fmaxf(__uint_as_float(rr[0]), __uint_as_float(rr[1])); }
  if (__builtin_expect(__all(pmax - m_reg <= THR / SCALE), 1)) { mn = m_reg; alpha = 1.f; }
  else { mn = fmaxf(m_reg, pmax); alpha = __builtin_amdgcn_exp2f((m_reg - mn) * C); m_reg = mn; }
  float mnC = -mn * C;
  for (int r = 0; r < 16; ++r) p0[r] = fmaf(p0[r], C, mnC); for (int r = 0; r < 16; ++r) p1[r] = fmaf(p1[r], C, mnC);
  for (int r = 0; r < 16; ++r) p0[r] = __builtin_amdgcn_exp2f(p0[r]);
}
#define PK4(P, BASE, OUT) do { unsigned a0 = cvtpk(P[BASE + 0], P[BASE + 1]), a1 = cvtpk(P[BASE + 2], P[BASE + 3]);   \
    unsigned b0 = cvtpk(P[BASE + 4], P[BASE + 5]), b1 = cvtpk(P[BASE + 6], P[BASE + 7]);                              \
    auto r0 = __builtin_amdgcn_permlane32_swap(a0, b0, false, false); auto r1 = __builtin_amdgcn_permlane32_swap(a1, b1, false, false); \
    u32x4 w = {r0[0], r1[0], r0[1], r1[1]}; OUT = *reinterpret_cast<bf16x8*>(&w); } while (0)
__device__ __forceinline__ void finishSM(f32x16& p0, f32x16& p1, float alpha, float& l_reg, bf16x8& pa0, bf16x8& pa1, bf16x8& pa2, bf16x8& pa3) {
  for (int r = 0; r < 16; ++r) p1[r] = __builtin_amdgcn_exp2f(p1[r]);
  float ps = 0; for (int r = 0; r < 16; ++r) ps += p0[r]; for (int r = 0; r < 16; ++r) ps += p1[r];
  { auto rr = __builtin_amdgcn_permlane32_swap(__float_as_uint(ps), __float_as_uint(ps), false, false);
    ps = __uint_as_float(rr[0]) + __uint_as_float(rr[1]); }
  l_reg = l_reg * alpha + ps;
  PK4(p0, 0, pa0); PK4(p0, 8, pa1); PK4(p1, 0, pa2); PK4(p1, 8, pa3);
}
__device__ __forceinline__ void qkt(f32x16& p0, f32x16& p1, const char* Ks, const bf16x8* qr, int r32, int hi) {
  p0 = f32x16{}; p1 = f32x16{};
#pragma unroll
  for (int d0 = 0; d0 < 8; ++d0) { int cb = (d0 * 16 + hi * 8) * 2;
    bf16x8 b0 = *reinterpret_cast<const bf16x8*>(Ks + KSWZ(r32, cb));
    bf16x8 b1 = *reinterpret_cast<const bf16x8*>(Ks + KSWZ(32 + r32, cb));
    p0 = __builtin_amdgcn_mfma_f32_32x32x16_bf16(b0, qr[d0], p0, 0, 0, 0);
    p1 = __builtin_amdgcn_mfma_f32_32x32x16_bf16(b1, qr[d0], p1, 0, 0, 0); }
}
__device__ __forceinline__ int v_st(int k, int c) { const int kk = (k & ~0xC) | ((k & 4) << 1) | ((k & 8) >> 1); return ((kk >> 3) * 4 + (c >> 5)) * 512 + ((kk & 7) * 32 + (c & 31)) * 2; }
__device__ __forceinline__ int v_rd_base(int lane) { return ((lane & 3) << 3) | (((lane >> 2) & 3) << 6) | (((lane >> 4) & 1) << 5) | (((lane >> 5) & 1) << 8); }
constexpr int v_rd_off(int d0, int ks, int half) { return d0 * 512 + ks * 4096 + half * 2048; }
template <int OFF> __device__ __forceinline__ s16x4 tr_read(int vb) {
  s16x4 r; asm volatile("ds_read_b64_tr_b16 %0, %1 offset:%2" : "=&v"(r) : "v"(vb), "i"(OFF) : "memory"); return r;
}
template <int D0> __device__ __forceinline__ void pv_one(f32x16& od, int vb, bf16x8 pa0, bf16x8 pa1, bf16x8 pa2, bf16x8 pa3) {
  const s16x4 l0 = tr_read<v_rd_off(D0, 0, 0)>(vb), h0 = tr_read<v_rd_off(D0, 0, 1)>(vb), l1 = tr_read<v_rd_off(D0, 1, 0)>(vb), h1 = tr_read<v_rd_off(D0, 1, 1)>(vb);
  const s16x4 l2 = tr_read<v_rd_off(D0, 2, 0)>(vb), h2 = tr_read<v_rd_off(D0, 2, 1)>(vb), l3 = tr_read<v_rd_off(D0, 3, 0)>(vb), h3 = tr_read<v_rd_off(D0, 3, 1)>(vb);
  asm volatile("s_waitcnt lgkmcnt(0)" ::: "memory"); SBAR();
#define PKV(L, H) (bf16x8){L[0], L[1], L[2], L[3], H[0], H[1], H[2], H[3]}
  od = __builtin_amdgcn_mfma_f32_32x32x16_bf16(pa0, PKV(l0, h0), od, 0, 0, 0);
  od = __builtin_amdgcn_mfma_f32_32x32x16_bf16(pa1, PKV(l1, h1), od, 0, 0, 0);
  od = __builtin_amdgcn_mfma_f32_32x32x16_bf16(pa2, PKV(l2, h2), od, 0, 0, 0);
  od = __builtin_amdgcn_mfma_f32_32x32x16_bf16(pa3, PKV(l3, h3), od, 0, 0, 0);
#undef PKV
}
__device__ __forceinline__ void pv_d0(f32x16* o, int vb, bf16x8 pa0, bf16x8 pa1, bf16x8 pa2, bf16x8 pa3) {
  pv_one<0>(o[0], vb, pa0, pa1, pa2, pa3); pv_one<1>(o[1], vb, pa0, pa1, pa2, pa3); pv_one<2>(o[2], vb, pa0, pa1, pa2, pa3); pv_one<3>(o[3], vb, pa0, pa1, pa2, pa3);
}

__device__ __forceinline__ void attn_dense_body(const bf16_t* __restrict__ Qb, int ldq, const bf16_t* __restrict__ Kh, const bf16_t* __restrict__ Vh, int ldk,
                                                bf16_t* __restrict__ Ob, int ldo, int seq, char* lds) {
  const int tid = threadIdx.x, wid = tid >> 6, lane = tid & 63, r32 = lane & 31, hi = lane >> 5;
  char* V_lds = lds; char* K_lds = lds + 2 * SHM_V;
  float* ws = (float*)(lds + 2 * SHM_V + 2 * SHM_K) + wid * 64; float* li_l = ws; float* al_l = ws + 32;
  float m_reg = -1e30f, l_reg = 0; f32x16 o[4] = {}; bf16x8 qr[8];
  const bf16_t* Qw = Qb + (long)(wid * QBLK + r32) * ldq + hi * 8;
#pragma unroll
  for (int d0 = 0; d0 < 8; ++d0) qr[d0] = *reinterpret_cast<const bf16x8*>(Qw + d0 * 16);
  const int sr = tid >> 4, sc = (tid & 15) * 8, vst0 = v_st(sr, sc), vst1 = v_st(32 + sr, sc);
  const int vb0 = (int)(uintptr_t)V_lds + v_rd_base(lane);
  struct { bf16x8 vs0, vs1, ks0, ks1; } sr_[2];
#define SLOAD(i, k0) do { sr_[i].vs0 = *reinterpret_cast<const bf16x8*>(&Vh[(long)((k0) + sr) * ldk + sc]); sr_[i].vs1 = *reinterpret_cast<const bf16x8*>(&Vh[(long)((k0) + 32 + sr) * ldk + sc]); \
    sr_[i].ks0 = *reinterpret_cast<const bf16x8*>(&Kh[(long)((k0) + sr) * ldk + sc]); sr_[i].ks1 = *reinterpret_cast<const bf16x8*>(&Kh[(long)((k0) + 32 + sr) * ldk + sc]); } while (0)
#define SWRITE(b, i) do { *(bf16x8*)(V_lds + (b) * SHM_V + vst0) = sr_[i].vs0;          \
    *(bf16x8*)(V_lds + (b) * SHM_V + vst1) = sr_[i].vs1; int kc = sc * 2;               \
    *(bf16x8*)(K_lds + (b) * SHM_K + KSWZ(sr, kc)) = sr_[i].ks0;                       \
    *(bf16x8*)(K_lds + (b) * SHM_K + KSWZ(32 + sr, kc)) = sr_[i].ks1; } while (0)
#define SWAIT() asm volatile("s_waitcnt vmcnt(4)" ::: "memory")
#define RESC(a) do { if (__any((a) < 1.f)) { if (hi == 0) al_l[r32] = (a); asm volatile("s_waitcnt lgkmcnt(0)" ::: "memory"); \
    for (int d = 0; d < 4; ++d) for (int r = 0; r < 16; ++r) o[d][r] *= al_l[crow(r, hi)]; } } while (0)
  f32x16 pA0, pA1, pB0, pB1; float mnA, mnB, alA, alB; bf16x8 pa0, pa1, pa2, pa3; const int NT = seq / KVBLK;
  constexpr int SE = 0, SO = 1;
  SLOAD(SE, 0); asm volatile("s_waitcnt vmcnt(0)" ::: "memory"); SWRITE(0, SE); __syncthreads();
  qkt(pA0, pA1, K_lds, qr, r32, hi); partialSM(pA0, pA1, m_reg, mnA, alA);
  SLOAD(SO, KVBLK); if (2 < NT) SLOAD(SE, 2 * KVBLK);
  SWAIT(); SWRITE(1, SO); __syncthreads();
  for (int j = 1; j + 1 < NT; j += 2) {
    SBAR(); qkt(pB0, pB1, K_lds + SHM_K, qr, r32, hi);
    finishSM(pA0, pA1, alA, l_reg, pa0, pa1, pa2, pa3); SBAR();
    SLOAD(SO, (j + 2) * KVBLK); SBAR();
    pv_d0(o, vb0, pa0, pa1, pa2, pa3); partialSM(pB0, pB1, m_reg, mnB, alB);
    __syncthreads(); SWAIT(); SWRITE(0, SE);
    RESC(alB); __syncthreads();
    SBAR(); qkt(pA0, pA1, K_lds, qr, r32, hi);
    finishSM(pB0, pB1, alB, l_reg, pa0, pa1, pa2, pa3); SBAR();
    if (j + 3 < NT) SLOAD(SE, (j + 3) * KVBLK); SBAR();
    pv_d0(o, vb0 + (int)SHM_V, pa0, pa1, pa2, pa3); partialSM(pA0, pA1, m_reg, mnA, alA);
    __syncthreads(); SWAIT(); SWRITE(1, SO);
    RESC(alA); __syncthreads();
  }
  SBAR(); qkt(pB0, pB1, K_lds + SHM_K, qr, r32, hi);
  finishSM(pA0, pA1, alA, l_reg, pa0, pa1, pa2, pa3); SBAR();
  pv_d0(o, vb0, pa0, pa1, pa2, pa3); partialSM(pB0, pB1, m_reg, mnB, alB);
  __syncthreads(); RESC(alB);
  finishSM(pB0, pB1, alB, l_reg, pa0, pa1, pa2, pa3); SBAR();
  pv_d0(o, vb0 + (int)SHM_V, pa0, pa1, pa2, pa3);
  if (hi == 0) li_l[r32] = l_reg; asm volatile("s_waitcnt lgkmcnt(0)" ::: "memory");
  float rli[16];
#pragma unroll
  for (int r = 0; r < 16; ++r) rli[r] = __builtin_amdgcn_rcpf(li_l[crow(r, hi)]);
  bf16_t* Ow = Ob + (long)(wid * QBLK) * ldo;
#pragma unroll
  for (int r = 0; r < 16; ++r) { int orow = crow(r, hi);
#pragma unroll
    for (int d0 = 0; d0 < 4; ++d0) Ow[(long)orow * ldo + d0 * 32 + r32] = (bf16_t)(cvtpk(o[d0][r] * rli[r], 0.f) & 0xffffu); }
  __syncthreads();
#undef SWAIT
#undef RESC
}

template <bool MASK> __device__ __forceinline__ float sb_half(f32x16& p, int kvis, int hi, float Lbase) {
  constexpr float C = SCALE * 1.4426950408889634f;
  float f[16];
#pragma unroll
  for (int r = 0; r < 16; ++r) { const float z = p[r] * C, e = __builtin_amdgcn_exp2f(-fabsf(z)), lg = __builtin_amdgcn_logf(1.0f + e);
    const float lb = fminf(z, 0.f) - lg;
    const float lf = lb - z;
    if (MASK) { const bool vis = crow(r, hi) < kvis; f[r] = vis ? lf : 0.f; p[r] = vis ? lb : -1e30f; } else { f[r] = lf; p[r] = lb; } }
  float IS[5]; IS[4] = 0.f;
#pragma unroll
  for (int og = 3; og >= 0; --og) IS[og] = IS[og + 1] + ((f[4 * og] + f[4 * og + 1]) + (f[4 * og + 2] + f[4 * og + 3]));
  float PS[4];
#pragma unroll
  for (int og = 0; og < 4; ++og) { const float x = hi ? IS[og] : IS[og + 1]; auto rr = __builtin_amdgcn_permlane32_swap(__float_as_uint(x), __float_as_uint(x), false, false);
    PS[og] = hi ? __uint_as_float(rr[0]) : __uint_as_float(rr[1]); }
  float TP; { auto rr = __builtin_amdgcn_permlane32_swap(__float_as_uint(IS[0]), __float_as_uint(IS[0]), false, false); TP = hi ? __uint_as_float(rr[0]) : __uint_as_float(rr[1]); }
#pragma unroll
  for (int og = 0; og < 4; ++og) { const int b = 4 * og; float la = Lbase + IS[og + 1] + PS[og];
    p[b + 3] += la; la += f[b + 3]; p[b + 2] += la; la += f[b + 2]; p[b + 1] += la; la += f[b + 1]; p[b] += la; }
  return IS[0] + TP;
}
__device__ __forceinline__ void attn_sb_body(const bf16_t* __restrict__ Qb, const bf16_t* __restrict__ Kh, const bf16_t* __restrict__ Vh, int ld,
                                             bf16_t* __restrict__ Ob, int ldo, int qb, char* lds) {
  const int tid = threadIdx.x, wid = tid >> 6, lane = tid & 63, r32 = lane & 31, hi = lane >> 5;
  char* V_lds = lds; char* K_lds = lds + 2 * SHM_V;
  f32x16 o[4] = {}; bf16x8 qr[8];
  const bf16_t* Qw = Qb + (long)(wid * QBLK + r32) * ld + hi * 8;
#pragma unroll
  for (int d0 = 0; d0 < 8; ++d0) qr[d0] = *reinterpret_cast<const bf16x8*>(Qw + d0 * 16);
  const int vb0 = (int)(uintptr_t)V_lds + v_rd_base(lane);
  unsigned voffK[2], voffV[2];
#pragma unroll
  for (int i = 0; i < 2; ++i) { const int o = (tid + 512 * i) * 16;
    { const int row = o >> 8, colB = (o & 255) ^ ((row & 7) << 4); voffK[i] = (unsigned)(row * ld * 2 + colB); }
    { const int sub = o >> 9, in = (o & 511) >> 1, kk = (sub >> 2) * 8 + (in >> 5), c = (sub & 3) * 32 + (in & 31), k = (kk & ~0xC) | ((kk & 4) << 1) | ((kk & 8) >> 1); voffV[i] = (unsigned)(k * ld * 2 + c * 2); } }
  const unsigned ldsV = (unsigned)(uintptr_t)V_lds + (unsigned)__builtin_amdgcn_readfirstlane(wid) * 1024u, ldsK = ldsV + 3u * (unsigned)SHM_V;
#define SB_STAGE(b, k0) do { const char* kp_ = (const char*)(Kh + (long)(k0) * ld); const char* vp_ = (const char*)(Vh + (long)(k0) * ld); \
    pg8::glds16(kp_, voffK[0], ldsK + (unsigned)(b) * (unsigned)SHM_K); pg8::glds16(kp_, voffK[1], ldsK + (unsigned)(b) * (unsigned)SHM_K + 8192u); \
    pg8::glds16(vp_, voffV[0], ldsV + (unsigned)(b) * (unsigned)SHM_V); pg8::glds16(vp_, voffV[1], ldsV + (unsigned)(b) * (unsigned)SHM_V + 8192u); } while (0)
  const int NT = 4 * (qb + 1);
  const int t0w = qb * 256 + wid * QBLK;
  const int tq = t0w + r32;
  float L = 0.f;
  char* K3 = lds + 3 * SHM_V;
  int* done_l = (int*)(lds + 3 * SHM_V + 3 * SHM_K);
  SB_STAGE(0, (NT - 1) * KVBLK); SB_STAGE(1, (NT - 2) * KVBLK);
  asm volatile("s_waitcnt vmcnt(4)" ::: "memory"); __syncthreads();
  int buf = 0;
  for (int j = 0; j < NT; ++j) {
    const int s0 = (NT - 1 - j) * KVBLK;
    { const int b2 = buf >= 1 ? buf - 1 : 2; if (j + 2 < NT) SB_STAGE(b2, s0 - 2 * KVBLK); }
    if (s0 < t0w + QBLK && !__all(L < -152.0f)) {
      f32x16 p0, p1;
      qkt(p0, p1, K3 + buf * SHM_K, qr, r32, hi);
      const int kmax = tq - s0;
      float tot0, tot1;
      if (s0 + KVBLK <= t0w) { tot1 = sb_half<false>(p1, 64, hi, L); tot0 = sb_half<false>(p0, 64, hi, L + tot1); }
      else { tot1 = sb_half<true>(p1, kmax - 32, hi, L); tot0 = sb_half<true>(p0, kmax, hi, L + tot1); }
      L += tot0 + tot1;
#pragma unroll
      for (int r = 0; r < 16; ++r) { p0[r] = __builtin_amdgcn_exp2f(p0[r]); p1[r] = __builtin_amdgcn_exp2f(p1[r]); }
      bf16x8 pa0, pa1, pa2, pa3;
      PK4(p0, 0, pa0); PK4(p0, 8, pa1); PK4(p1, 0, pa2); PK4(p1, 8, pa3);
      SBAR();
      pv_d0(o, vb0 + buf * (int)SHM_V, pa0, pa1, pa2, pa3);
    }
    { const int wd = __all(L < -152.0f) ? 1 : 0; if (lane == 0) done_l[(j & 1) * 8 + wid] = wd; }
    if (j + 2 < NT) asm volatile("s_waitcnt vmcnt(4) lgkmcnt(0)" ::: "memory");
    else asm volatile("s_waitcnt vmcnt(0) lgkmcnt(0)" ::: "memory");
    __syncthreads();
    { int dn = 1;
#pragma unroll
      for (int w = 0; w < 8; ++w) dn &= done_l[(j & 1) * 8 + w];
      if (dn) break; }
    buf = buf == 2 ? 0 : buf + 1;
  }
  asm volatile("s_waitcnt vmcnt(0)" ::: "memory"); __syncthreads();
  bf16_t* Ow = Ob + (long)(wid * QBLK) * ldo;
#pragma unroll
  for (int r = 0; r < 16; ++r) { int orow = crow(r, hi);
#pragma unroll
    for (int d0 = 0; d0 < 4; ++d0) Ow[(long)orow * ldo + d0 * 32 + r32] = (bf16_t)(cvtpk(o[d0][r], 0.f) & 0xffffu); }
#undef SB_STAGE
}
#undef SLOAD
#undef SWRITE
}

#define XB_TMO      128
#define XB_XCNT(j)  (256  + 64 * (j))
#define XB_XSUB(j)  (1280 + 64 * (j))
#define XB_XGEN(j)  (2304 + 64 * (j))
#define XB_TOP      3328
#define XB_TOPGEN   3392
#define XCD_BAR_WORDS 3456
#define XB_SPIN_CAP (1u << 20)
__device__ __forceinline__ unsigned xb_ld(unsigned* p)              { return __hip_atomic_load(p, __ATOMIC_RELAXED, __HIP_MEMORY_SCOPE_AGENT); }
__device__ __forceinline__ unsigned xb_add(unsigned* p, unsigned v) { return __hip_atomic_fetch_add(p, v, __ATOMIC_RELAXED, __HIP_MEMORY_SCOPE_AGENT); }
__device__ __forceinline__ unsigned xb_xcc_id() { return (unsigned)__builtin_amdgcn_s_getreg((3 << 11) | 20) & 0xFu; }
#define XB_SPIN(cond, bar) do { unsigned _sp = 0; while (cond) { __builtin_amdgcn_s_sleep(1); \
    if ((++_sp & 255u) == 0u) { if (xb_ld(&(bar)[XB_TMO])) break; if (_sp > XB_SPIN_CAP) { atomicAdd(&(bar)[XB_TMO], 1u); break; } } } } while (0)
struct XcdBarrier { unsigned* bar; unsigned x; volatile LAS unsigned* st; };
__device__ __forceinline__ XcdBarrier xcd_barrier_post(unsigned* bar, volatile LAS unsigned* st) {
    XcdBarrier b; b.bar = bar; b.x = xb_xcc_id(); b.st = st;
    if (threadIdx.x == 0) (void)xb_add(&bar[XB_XCNT(b.x)], 1u);
    return b;
}
__device__ __forceinline__ void xcd_barrier_complete(unsigned* bar, unsigned x, unsigned& nloc, unsigned& nx) {
    const unsigned G = gridDim.x * gridDim.y * gridDim.z;
    unsigned sum, cnt, mine, sp = 0u;
    for (;;) {
        sum = 0u; cnt = 0u; mine = 0u;
#pragma unroll
        for (unsigned j = 0; j < 16; ++j) { const unsigned c = xb_ld(&bar[XB_XCNT(j)]); sum += c; cnt += (c > 0u) ? 1u : 0u; mine = (j == x) ? c : mine; }
        if (sum == G) break;
        __builtin_amdgcn_s_sleep(1);
        if ((++sp & 255u) == 0u) { if (xb_ld(&bar[XB_TMO])) break; if (sp > XB_SPIN_CAP) { atomicAdd(&bar[XB_TMO], 1u); break; } }
    }
    nloc = mine > 0u ? mine : 1u; nx = cnt > 0u ? cnt : 1u;
}
__device__ __forceinline__ void xcd_barrier(const XcdBarrier& b) {
    asm volatile("s_waitcnt vmcnt(0)" ::: "memory");
    __syncthreads();
    if (threadIdx.x == 0) {
        unsigned* bar = b.bar;
        __builtin_amdgcn_s_waitcnt(0);
        unsigned nloc = b.st[0], nx = b.st[1];
        if (nloc == 0u) { xcd_barrier_complete(bar, b.x, nloc, nx); b.st[0] = nloc; b.st[1] = nx; }
        const unsigned old = xb_add(&bar[XB_XSUB(b.x)], 1u);
        const unsigned gen = old / nloc;
        if (old + 1u == (gen + 1u) * nloc) {
            __builtin_amdgcn_fence(__ATOMIC_RELEASE, "agent");
            asm volatile("s_waitcnt vmcnt(0)" ::: "memory");
            const unsigned og = xb_add(&bar[XB_TOP], 1u);
            const unsigned tg = og / nx;
            if (og + 1u == (tg + 1u) * nx) xb_add(&bar[XB_TOPGEN], 1u);
            else XB_SPIN(xb_ld(&bar[XB_TOPGEN]) == tg, bar);
            __builtin_amdgcn_fence(__ATOMIC_ACQUIRE, "agent");
            xb_add(&bar[XB_XGEN(b.x)], 1u);
            asm volatile("s_waitcnt vmcnt(0)" ::: "memory");
        } else {
            XB_SPIN(xb_ld(&bar[XB_XGEN(b.x)]) == gen, bar);
            __builtin_amdgcn_fence(__ATOMIC_ACQUIRE, "agent");
            asm volatile("s_waitcnt vmcnt(0)" ::: "memory");
        }
    }
    __syncthreads();
}

struct Args { const float* in[22]; float* out; unsigned char* ws; int ph_lo, ph_hi; };
enum { I_X = 0, I_MEM, I_NMIXG, I_NMEMG, I_WIN, I_WPG, I_PSCALE, I_WPP, I_WSB, I_WKV, I_WMP, I_WOUT, I_NFFNG, I_WR, I_BR, I_WGATE, I_BGATE, I_WUP, I_BUP, I_WDOWN, I_BDOWN, I_NFING };

template <bool FP8> __device__ __forceinline__ void cvt_t_item(const float* W, int K, int N, void* WT, float scale, int item, int lane, int ldo = 0, int coff = 0) {
    if (ldo == 0) ldo = K;
    const int nkb = K / 16, nb = item / nkb, kb = item - nb * nkb, k0 = 16 * kb, n0 = 256 * nb + 4 * lane;
    f32x4 v[16];
#pragma unroll
    for (int r = 0; r < 16; ++r) v[r] = *(const f32x4*)(W + (size_t)(k0 + r) * N + n0);
#pragma unroll
    for (int j = 0; j < 4; ++j) {
        if constexpr (FP8) { u32x4 o; o.x = pg8::pk4_fp8(v[0][j] * scale, v[1][j] * scale, v[2][j] * scale, v[3][j] * scale); o.y = pg8::pk4_fp8(v[4][j] * scale, v[5][j] * scale, v[6][j] * scale, v[7][j] * scale);
            o.z = pg8::pk4_fp8(v[8][j] * scale, v[9][j] * scale, v[10][j] * scale, v[11][j] * scale); o.w = pg8::pk4_fp8(v[12][j] * scale, v[13][j] * scale, v[14][j] * scale, v[15][j] * scale);
            *(u32x4*)((unsigned char*)WT + (size_t)(n0 + j) * ldo + coff + k0) = o; }
        else { u32x4 o0, o1; o0.x = cvt_pk_bf16(v[0][j], v[1][j]); o0.y = cvt_pk_bf16(v[2][j], v[3][j]); o0.z = cvt_pk_bf16(v[4][j], v[5][j]); o0.w = cvt_pk_bf16(v[6][j], v[7][j]);
            o1.x = cvt_pk_bf16(v[8][j], v[9][j]); o1.y = cvt_pk_bf16(v[10][j], v[11][j]); o1.z = cvt_pk_bf16(v[12][j], v[13][j]); o1.w = cvt_pk_bf16(v[14][j], v[15][j]);
            u32x4* d = (u32x4*)((bf16_t*)WT + (size_t)(n0 + j) * ldo + coff + k0); d[0] = o0; d[1] = o1; }
    }
}
__device__ __forceinline__ void rms_row_to_bf16(const float* xrow, const float* g, bf16_t* orow, int lane, unsigned char* orow8 = nullptr) {
    const f32x4* xr = (const f32x4*)xrow + lane; const f32x4* gr = (const f32x4*)g + lane;
    f32x4 v[8]; float s = 0.f;
#pragma unroll
    for (int j = 0; j < 8; ++j) { v[j] = xr[64 * j]; s += (v[j].x * v[j].x + v[j].y * v[j].y) + (v[j].z * v[j].z + v[j].w * v[j].w); }
    const float rstd = 1.0f / sqrtf(wave_sum(s) * (1.f / DM) + EPS);
    u32x2* o8 = (u32x2*)orow + lane; unsigned* o4 = (unsigned*)orow8 + lane;
#pragma unroll
    for (int j = 0; j < 8; ++j) { const f32x4 gg = gr[64 * j]; const float a = v[j].x * rstd * gg.x, b = v[j].y * rstd * gg.y, c = v[j].z * rstd * gg.z, d = v[j].w * rstd * gg.w;
        u32x2 w; w.x = cvt_pk_bf16(a, b); w.y = cvt_pk_bf16(c, d); o8[64 * j] = w; if (orow8) o4[64 * j] = pg8::pk4_fp8(a, b, c, d); }
}

__device__ __forceinline__ void build_moe_tables(LAS int* tab, const unsigned* gcount) {
    if (threadIdx.x < NE) { int c = (int)__hip_atomic_load(gcount + threadIdx.x, __ATOMIC_RELAXED, __HIP_MEMORY_SCOPE_AGENT); if (c > CAP) c = CAP; tab[96 + threadIdx.x] = c; }
    __syncthreads();
    if (threadIdx.x == 0) {
        int cum1 = 0, cum2 = 0, tiles = 0;
        for (int e = 0; e < NE; ++e) { const int c = tab[96 + e]; const int ntm = (c + 255) >> 8;
            tab[32 + e] = ntm; tab[64 + e] = tiles; tiles += ntm; cum1 += ntm * 16; cum2 += ntm * 8; tab[e] = cum1; tab[128 + e] = cum2; }
        tab[160] = tiles;
    }
    __syncthreads();
}

__global__ void __launch_bounds__(NTHR, 2) fwd(Args args) {
    extern __shared__ __attribute__((aligned(16))) unsigned char lds_raw[];
    LAS unsigned char* lds = (LAS unsigned char*)lds_raw;
    volatile LAS unsigned* MISC = (volatile LAS unsigned*)(lds + LDS_MISC);
    LAS int* tab = (LAS int*)(lds + LDS_TAB);
    const int tid = threadIdx.x, lane = tid & 63, wave = __builtin_amdgcn_readfirstlane(tid >> 6);
    const int G = gridDim.x, bx = blockIdx.x, vcu = (G % 8 == 0) ? (bx % 8) * (G / 8) + bx / 8 : bx;
    unsigned char* ws = args.ws;
    unsigned* ctl = (unsigned*)(ws + WS_CTL);
    const int lo = args.ph_lo, hi = args.ph_hi;
    const bool multi = (hi - lo) > 1;
    if (tid < 32) MISC[tid] = 0u;
    __syncthreads();
    XcdBarrier bar; bar.bar = ctl + CW_BAR; bar.x = 0; bar.st = nullptr;
    if (multi) bar = xcd_barrier_post(ctl + CW_BAR, MISC + 8);
#define IN(k) (lo <= (k) && (k) < hi)
#define SEAM(k) do { if (IN(k) && IN((k) + 1)) xcd_barrier(bar); } while (0)
    const float* x = args.in[I_X];
    bf16_t* WinT = (bf16_t*)(ws + WS_WIN); unsigned char* WinG8 = ws + WS_WING8; unsigned char* XN8 = ws + WS_XN8; bf16_t* WmixT = (bf16_t*)(ws + WS_WMIX); bf16_t* WkvT = (bf16_t*)(ws + WS_WKV);
    bf16_t* WoutT = (bf16_t*)(ws + WS_WOUT); unsigned char* WgT = ws + WS_WG; unsigned char* WuT = ws + WS_WU; unsigned char* WdT = ws + WS_WD;
    bf16_t* Pb = (bf16_t*)(ws + WS_P); unsigned char* Act = ws + WS_ACT; bf16_t* XN = (bf16_t*)(ws + WS_XN); bf16_t* MEMN = (bf16_t*)(ws + WS_MEMN); bf16_t* KVXA = (bf16_t*)(ws + WS_KVXA);
    bf16_t* MIX = (bf16_t*)(ws + WS_MIX); bf16_t* MERGED = (bf16_t*)(ws + WS_MERGED);
    int* ROWSTOK = (int*)(ws + WS_ROWSTOK); float* GATEW = (float*)(ws + WS_GATEW); int* TOKSLOT = (int*)(ws + WS_TOKSLOT); unsigned char* Yb = ws + WS_Y;
    unsigned char* Gate8 = ws + WS_GATE8;
    unsigned* gcount = ctl + CW_GCOUNT; float* WRT = (float*)(ws + WS_WRT); float* RSTDW = (float*)(ws + WS_RSTDW);
    bf16_t* Hb = (bf16_t*)(ws + WS_XN);
    unsigned char* H8 = ws + WS_HN;
    const int gw = vcu * NWAVES + wave, NGW = G * NWAVES;

    if (IN(0)) {
        constexpr int I0 = (DM / 16) * (C_GATE / 256), I1 = (1024 / 16) * (DM / 256), I2 = (DM / 16) * (1024 / 256), I3 = (512 / 16) * (DM / 256), I4 = (DM / 16) * (DM / 256);
        for (int m = gw; m < MEMR; m += NGW) rms_row_to_bf16(args.in[I_MEM] + (size_t)m * DM, args.in[I_NMEMG], MEMN + (size_t)m * DM, lane);
        for (int it = gw; it < I2; it += NGW) cvt_t_item<false>(args.in[I_WKV], DM, 1024, WkvT, 1.f, it, lane);
        constexpr int NIT = I0 + I1 + I3 + I4;
        for (int it = gw; it < NIT; it += NGW) {
            int r = it;
            if (r < I0) { cvt_t_item<false>(args.in[I_WIN], DM, INW, WinT, 1.f, r, lane); continue; } r -= I0;
            if (r < I1) { cvt_t_item<false>(args.in[I_WSB], 1024, DM, WmixT, 1.f, r, lane, DM, 512); continue; } r -= I1;
            if (r < I3) { cvt_t_item<false>(args.in[I_WMP], 512, DM, WmixT, 1.f, r, lane, DM, 1536); continue; } r -= I3;
            cvt_t_item<true>(args.in[I_WOUT], DM, DM, WoutT, pg8::W_SCALE, r, lane);
        }
        for (int it = gw; it < 4 * 4 * 64; it += NGW) {
            const int g = it >> 8, cb = (it >> 6) & 3, nb = it & 63, r32 = lane & 31, hh = lane >> 5;
            const float* Wgp = args.in[I_WPG] + ((size_t)g * 128 + cb * 32 + r32) * 128 + 4 * hh;
            const float* scp = args.in[I_PSCALE] + g * 128 + 4 * hh;
            const float* Wpp = args.in[I_WPP] + ((size_t)g * 128 + 4 * hh) * DM + nb * 32 + r32;
            f32x16 acc = {};
            f32x4 a4[16], s4[16]; float bq[16][4];
#pragma unroll
            for (int s8 = 0; s8 < 16; ++s8) { a4[s8] = *(const f32x4*)(Wgp + 8 * s8); s4[s8] = *(const f32x4*)(scp + 8 * s8);
#pragma unroll
                for (int j = 0; j < 4; ++j) bq[s8][j] = Wpp[(size_t)(8 * s8 + j) * DM]; }
#pragma unroll
            for (int s8 = 0; s8 < 16; ++s8)
#pragma unroll
                for (int j = 0; j < 4; ++j) acc = __builtin_amdgcn_mfma_f32_32x32x2f32(a4[s8][j], s4[s8][j] * bq[s8][j], acc, 0, 0, 0);
            bf16_t* dst = WmixT + (size_t)(nb * 32 + r32) * DM + g * 128 + cb * 32 + 4 * hh;
#pragma unroll
            for (int q = 0; q < 4; ++q) { u32x2 w; w.x = cvt_pk_bf16(acc[4 * q], acc[4 * q + 1]); w.y = cvt_pk_bf16(acc[4 * q + 2], acc[4 * q + 3]); *(u32x2*)(dst + 8 * q) = w; }
        }
        for (int i = gw * 64 + lane; i < NE * DM; i += NGW * 64) { const int e = i >> 11, k = i & (DM - 1); WRT[i] = args.in[I_WR][(size_t)k * NE + e] * args.in[I_NFFNG][k]; }
        for (int m = gw; m < T; m += NGW) rms_row_to_bf16(x + (size_t)m * DM, args.in[I_NMIXG], XN + (size_t)m * DM, lane, XN8 + (size_t)m * DM);
        __syncthreads();
        {
            constexpr int NWX = 3 * NE * 128, NWI = NWX + 16 * 24;
            const int nitems = (NWI - NWX - vcu + G - 1) / G;
#define CV_ITEM(i) (NWX + vcu + (i) * G)
            LAS float* gsc = (LAS float*)(lds + 65536);
            for (int k = tid; k < DM; k += NTHR) gsc[k] = pg8::W_SCALE * args.in[I_NFFNG][k];
            __syncthreads();
            const int n4 = 4 * lane;
            f32x4 vA[16], vB[16];
#define CV_LOAD(v, item) do { const float* src_; size_t ns_; if ((item) < NWX) { const int mat_ = (item) >> 7, r_ = (item) & 127, nb_ = r_ & 7, kg_ = r_ >> 3, which_ = mat_ >> 5, e_ = mat_ & 31; ns_ = DFF; \
                    src_ = args.in[which_ == 0 ? I_WGATE : (which_ == 1 ? I_WUP : I_WDOWN)] + (size_t)e_ * DM * DFF + (size_t)(128 * kg_ + 16 * wave) * DFF + 256 * nb_ + n4; } \
                else { const int r_ = (item) - NWX, nb_ = r_ % 24, kg_ = r_ / 24; ns_ = INW; src_ = args.in[I_WIN] + (size_t)(128 * kg_ + 16 * wave) * INW + C_GATE + 256 * nb_ + n4; } \
                _Pragma("unroll") for (int r = 0; r < 16; ++r) v[r] = __builtin_nontemporal_load((const f32x4*)(src_ + (size_t)r * ns_)); } while (0)
#define CV_STEP(v, it, bsel, has_n, itn) do { LAS unsigned char* buf = lds + (bsel) * 32768; \
                { float ms[16]; const bool fold = (it) < 2 * NE * 128; const int kr0 = ((it) < NWX ? 128 * (((it) & 127) >> 3) : 0) + 16 * wave; \
                  _Pragma("unroll") for (int r = 0; r < 16; ++r) { const float gq_ = gsc[kr0 + r]; ms[r] = fold ? gq_ : pg8::W_SCALE; } \
                  _Pragma("unroll") for (int j = 0; j < 4; ++j) { u32x4 o; o.x = pg8::pk4_fp8(v[0][j] * ms[0], v[1][j] * ms[1], v[2][j] * ms[2], v[3][j] * ms[3]); o.y = pg8::pk4_fp8(v[4][j] * ms[4], v[5][j] * ms[5], v[6][j] * ms[6], v[7][j] * ms[7]); \
                    o.z = pg8::pk4_fp8(v[8][j] * ms[8], v[9][j] * ms[9], v[10][j] * ms[10], v[11][j] * ms[11]); o.w = pg8::pk4_fp8(v[12][j] * ms[12], v[13][j] * ms[13], v[14][j] * ms[14], v[15][j] * ms[15]); \
                    *(LAS u32x4*)(buf + (n4 + j) * 128 + ((wave ^ (lane & 7)) << 4)) = o; } } \
                const int mat = (it) >> 7, r7 = (it) & 127, which = mat >> 5, e = mat & 31; \
                const int nb = (it) < NWX ? (r7 & 7) : ((it) - NWX) % 24, kg = (it) < NWX ? (r7 >> 3) : ((it) - NWX) / 24; \
                CV_LOAD(v, itn); \
                __syncthreads(); \
                unsigned char* dst = ((it) < NWX ? (which == 0 ? WgT : (which == 1 ? WuT : WdT)) + (size_t)e * DM * DFF : WinG8) + (size_t)(256 * nb) * DM + 128 * kg + 16 * (lane & 7); \
                _Pragma("unroll") for (int q4 = 0; q4 < 4; ++q4) { const int row = wave * 32 + q4 * 8 + (lane >> 3);     \
                    const u32x4 o = *(const LAS u32x4*)(buf + row * 128 + (((lane & 7) ^ ((row >> 2) & 7)) << 4)); *(u32x4*)(dst + (size_t)row * DM) = o; } } while (0)
#define CV_CL(i_) CV_ITEM((i_) < nitems ? (i_) : nitems - 1)
            if (nitems > 0) { CV_LOAD(vA, CV_CL(0)); CV_LOAD(vB, CV_CL(1));
                for (int i = 0; i < nitems; i += 2) {
                    { const int it = CV_CL(i); CV_STEP(vA, it, 0, true, CV_CL(i + 2)); }
                    { const int it = CV_CL(i + 1); CV_STEP(vB, it, 1, true, CV_CL(i + 3)); }
                } }
#undef CV_CL
#undef CV_STEP
#undef CV_LOAD
#undef CV_ITEM
            __syncthreads();
        }
    }
    SEAM(0);

    if (IN(1))
    {
        const bool mkwg = bx < 32; const int grp = (G == 256) ? ((bx >> 3) & 31) % 3 : 0;
        if (mkwg) { pg8::DenseProb P; P.init(MEMN, WkvT, MEMR, 1024, DM, G, bx); pg8::EpiStoreBf16 E{KVXA, 1024, 1 << 30, 1.f}; pg8::gemm_phase(lds, P, E); }
        if (grp == 0) {
        {
            constexpr int NWX = 3 * NE * 128, NWI = NWX + 16 * 24;
            const bool stag = (G == 256);
            const int b5 = vcu & 31, a5 = vcu >> 5, cntg = (31 - grp) / 3 + 1, ng = stag ? cntg * (G >> 5) : G, q = stag ? a5 * cntg + b5 / 3 : vcu;
            const int ibase = stag ? (int)((long)NWX * (grp == 0 ? 0 : (grp == 1 ? 11 : 22)) / 32) : 0, iend = stag ? (int)((long)NWX * (grp == 0 ? 11 : (grp == 1 ? 22 : 32)) / 32) : NWX;
            const int nitems = (iend - ibase - q + ng - 1) / ng;
#define CV_ITEM(i) (ibase + q + (i) * ng)
            LAS float* gsc = (LAS float*)(lds + 65536);
            for (int k = tid; k < DM; k += NTHR) gsc[k] = pg8::W_SCALE * args.in[I_NFFNG][k];
            __syncthreads();
            const int n4 = 4 * lane;
            f32x4 vA[16], vB[16];
#define CV_LOAD(v, item) do { const float* src_; size_t ns_; if ((item) < NWX) { const int mat_ = (item) >> 7, r_ = (item) & 127, nb_ = r_ & 7, kg_ = r_ >> 3, which_ = mat_ >> 5, e_ = mat_ & 31; ns_ = DFF; \
                    src_ = args.in[which_ == 0 ? I_WGATE : (which_ == 1 ? I_WUP : I_WDOWN)] + (size_t)e_ * DM * DFF + (size_t)(128 * kg_ + 16 * wave) * DFF + 256 * nb_ + n4; } \
                else { const int r_ = (item) - NWX, nb_ = r_ % 24, kg_ = r_ / 24; ns_ = INW; src_ = args.in[I_WIN] + (size_t)(128 * kg_ + 16 * wave) * INW + C_GATE + 256 * nb_ + n4; } \
                _Pragma("unroll") for (int r = 0; r < 16; ++r) v[r] = __builtin_nontemporal_load((const f32x4*)(src_ + (size_t)r * ns_)); } while (0)
#define CV_STEP(v, it, bsel, has_n, itn) do { LAS unsigned char* buf = lds + (bsel) * 32768; \
                { float ms[16]; const bool fold = (it) < 2 * NE * 128; const int kr0 = ((it) < NWX ? 128 * (((it) & 127) >> 3) : 0) + 16 * wave; \
                  _Pragma("unroll") for (int r = 0; r < 16; ++r) { const float gq_ = gsc[kr0 + r]; ms[r] = fold ? gq_ : pg8::W_SCALE; } \
                  _Pragma("unroll") for (int j = 0; j < 4; ++j) { u32x4 o; o.x = pg8::pk4_fp8(v[0][j] * ms[0], v[1][j] * ms[1], v[2][j] * ms[2], v[3][j] * ms[3]); o.y = pg8::pk4_fp8(v[4][j] * ms[4], v[5][j] * ms[5], v[6][j] * ms[6], v[7][j] * ms[7]); \
                    o.z = pg8::pk4_fp8(v[8][j] * ms[8], v[9][j] * ms[9], v[10][j] * ms[10], v[11][j] * ms[11]); o.w = pg8::pk4_fp8(v[12][j] * ms[12], v[13][j] * ms[13], v[14][j] * ms[14], v[15][j] * ms[15]); \
                    *(LAS u32x4*)(buf + (n4 + j) * 128 + ((wave ^ (lane & 7)) << 4)) = o; } } \
                const int mat = (it) >> 7, r7 = (it) & 127, which = mat >> 5, e = mat & 31; \
                const int nb = (it) < NWX ? (r7 & 7) : ((it) - NWX) % 24, kg = (it) < NWX ? (r7 >> 3) : ((it) - NWX) / 24; \
                CV_LOAD(v, itn); \
                __syncthreads(); \
                unsigned char* dst = ((it) < NWX ? (which == 0 ? WgT : (which == 1 ? WuT : WdT)) + (size_t)e * DM * DFF : WinG8) + (size_t)(256 * nb) * DM + 128 * kg + 16 * (lane & 7); \
                _Pragma("unroll") for (int q4 = 0; q4 < 4; ++q4) { const int row = wave * 32 + q4 * 8 + (lane >> 3);     \
                    const u32x4 o = *(const LAS u32x4*)(buf + row * 128 + (((lane & 7) ^ ((row >> 2) & 7)) << 4)); *(u32x4*)(dst + (size_t)row * DM) = o; } } while (0)
#define CV_CL(i_) CV_ITEM((i_) < nitems ? (i_) : nitems - 1)
            if (nitems > 0) { CV_LOAD(vA, CV_CL(0)); CV_LOAD(vB, CV_CL(1));
                for (int i = 0; i < nitems; i += 2) {
                    { const int it = CV_CL(i); CV_STEP(vA, it, 0, true, CV_CL(i + 2)); }
                    { const int it = CV_CL(i + 1); CV_STEP(vB, it, 1, true, CV_CL(i + 3)); }
                } }
#undef CV_CL
#undef CV_STEP
#undef CV_LOAD
#undef CV_ITEM
            __syncthreads();
        }
        }
        { pg8::DenseProb P; P.init(XN, WinT, T, C_GATE, DM, G, bx); pg8::EpiStoreBf16 E{Pb, INW, 1 << 30, 1.f}; pg8::gemm_phase(lds, P, E); }
        if (grp == 1) {
        {
            constexpr int NWX = 3 * NE * 128, NWI = NWX + 16 * 24;
            const bool stag = (G == 256);
            const int b5 = vcu & 31, a5 = vcu >> 5, cntg = (31 - grp) / 3 + 1, ng = stag ? cntg * (G >> 5) : G, q = stag ? a5 * cntg + b5 / 3 : vcu;
            const int ibase = stag ? (int)((long)NWX * (grp == 0 ? 0 : (grp == 1 ? 11 : 22)) / 32) : 0, iend = stag ? (int)((long)NWX * (grp == 0 ? 11 : (grp == 1 ? 22 : 32)) / 32) : NWX;
            const int nitems = (iend - ibase - q + ng - 1) / ng;
#define CV_ITEM(i) (ibase + q + (i) * ng)
            LAS float* gsc = (LAS float*)(lds + 65536);
            for (int k = tid; k < DM; k += NTHR) gsc[k] = pg8::W_SCALE * args.in[I_NFFNG][k];
            __syncthreads();
            const int n4 = 4 * lane;
            f32x4 vA[16], vB[16];
#define CV_LOAD(v, item) do { const float* src_; size_t ns_; if ((item) < NWX) { const int mat_ = (item) >> 7, r_ = (item) & 127, nb_ = r_ & 7, kg_ = r_ >> 3, which_ = mat_ >> 5, e_ = mat_ & 31; ns_ = DFF; \
                    src_ = args.in[which_ == 0 ? I_WGATE : (which_ == 1 ? I_WUP : I_WDOWN)] + (size_t)e_ * DM * DFF + (size_t)(128 * kg_ + 16 * wave) * DFF + 256 * nb_ + n4; } \
                else { const int r_ = (item) - NWX, nb_ = r_ % 24, kg_ = r_ / 24; ns_ = INW; src_ = args.in[I_WIN] + (size_t)(128 * kg_ + 16 * wave) * INW + C_GATE + 256 * nb_ + n4; } \
                _Pragma("unroll") for (int r = 0; r < 16; ++r) v[r] = __builtin_nontemporal_load((const f32x4*)(src_ + (size_t)r * ns_)); } while (0)
#define CV_STEP(v, it, bsel, has_n, itn) do { LAS unsigned char* buf = lds + (bsel) * 32768; \
                { float ms[16]; const bool fold = (it) < 2 * NE * 128; const int kr0 = ((it) < NWX ? 128 * (((it) & 127) >> 3) : 0) + 16 * wave; \
                  _Pragma("unroll") for (int r = 0; r < 16; ++r) { const float gq_ = gsc[kr0 + r]; ms[r] = fold ? gq_ : pg8::W_SCALE; } \
                  _Pragma("unroll") for (int j = 0; j < 4; ++j) { u32x4 o; o.x = pg8::pk4_fp8(v[0][j] * ms[0], v[1][j] * ms[1], v[2][j] * ms[2], v[3][j] * ms[3]); o.y = pg8::pk4_fp8(v[4][j] * ms[4], v[5][j] * ms[5], v[6][j] * ms[6], v[7][j] * ms[7]); \
                    o.z = pg8::pk4_fp8(v[8][j] * ms[8], v[9][j] * ms[9], v[10][j] * ms[10], v[11][j] * ms[11]); o.w = pg8::pk4_fp8(v[12][j] * ms[12], v[13][j] * ms[13], v[14][j] * ms[14], v[15][j] * ms[15]); \
                    *(LAS u32x4*)(buf + (n4 + j) * 128 + ((wave ^ (lane & 7)) << 4)) = o; } } \
                const int mat = (it) >> 7, r7 = (it) & 127, which = mat >> 5, e = mat & 31; \
                const int nb = (it) < NWX ? (r7 & 7) : ((it) - NWX) % 24, kg = (it) < NWX ? (r7 >> 3) : ((it) - NWX) / 24; \
                CV_LOAD(v, itn); \
                __syncthreads(); \
                unsigned char* dst = ((it) < NWX ? (which == 0 ? WgT : (which == 1 ? WuT : WdT)) + (size_t)e * DM * DFF : WinG8) + (size_t)(256 * nb) * DM + 128 * kg + 16 * (lane & 7); \
                _Pragma("unroll") for (int q4 = 0; q4 < 4; ++q4) { const int row = wave * 32 + q4 * 8 + (lane >> 3);     \
                    const u32x4 o = *(const LAS u32x4*)(buf + row * 128 + (((lane & 7) ^ ((row >> 2) & 7)) << 4)); *(u32x4*)(dst + (size_t)row * DM) = o; } } while (0)
#define CV_CL(i_) CV_ITEM((i_) < nitems ? (i_) : nitems - 1)
            if (nitems > 0) { CV_LOAD(vA, CV_CL(0)); CV_LOAD(vB, CV_CL(1));
                for (int i = 0; i < nitems; i += 2) {
                    { const int it = CV_CL(i); CV_STEP(vA, it, 0, true, CV_CL(i + 2)); }
                    { const int it = CV_CL(i + 1); CV_STEP(vB, it, 1, true, CV_CL(i + 3)); }
                } }
#undef CV_CL
#undef CV_STEP
#undef CV_LOAD
#undef CV_ITEM
            __syncthreads();
        }
        }
        { pg8::DenseProb8 P; P.init(XN8, WinG8, T, INW - C_GATE, DM, G, bx); pg8::EpiGateU8 E{Gate8, 1.0f / pg8::W_SCALE}; pg8::gemm_phase(lds, P, E); }
        if (grp == 2) {
        {
            constexpr int NWX = 3 * NE * 128, NWI = NWX + 16 * 24;
            const bool stag = (G == 256);
            const int b5 = vcu & 31, a5 = vcu >> 5, cntg = (31 - grp) / 3 + 1, ng = stag ? cntg * (G >> 5) : G, q = stag ? a5 * cntg + b5 / 3 : vcu;
            const int ibase = stag ? (int)((long)NWX * (grp == 0 ? 0 : (grp == 1 ? 11 : 22)) / 32) : 0, iend = stag ? (int)((long)NWX * (grp == 0 ? 11 : (grp == 1 ? 22 : 32)) / 32) : NWX;
            const int nitems = (iend - ibase - q + ng - 1) / ng;
#define CV_ITEM(i) (ibase + q + (i) * ng)
            LAS float* gsc = (LAS float*)(lds + 65536);
            for (int k = tid; k < DM; k += NTHR) gsc[k] = pg8::W_SCALE * args.in[I_NFFNG][k];
            __syncthreads();
            const int n4 = 4 * lane;
            f32x4 vA[16], vB[16];
#define CV_LOAD(v, item) do { const float* src_; size_t ns_; if ((item) < NWX) { const int mat_ = (item) >> 7, r_ = (item) & 127, nb_ = r_ & 7, kg_ = r_ >> 3, which_ = mat_ >> 5, e_ = mat_ & 31; ns_ = DFF; \
                    src_ = args.in[which_ == 0 ? I_WGATE : (which_ == 1 ? I_WUP : I_WDOWN)] + (size_t)e_ * DM * DFF + (size_t)(128 * kg_ + 16 * wave) * DFF + 256 * nb_ + n4; } \
                else { const int r_ = (item) - NWX, nb_ = r_ % 24, kg_ = r_ / 24; ns_ = INW; src_ = args.in[I_WIN] + (size_t)(128 * kg_ + 16 * wave) * INW + C_GATE + 256 * nb_ + n4; } \
                _Pragma("unroll") for (int r = 0; r < 16; ++r) v[r] = __builtin_nontemporal_load((const f32x4*)(src_ + (size_t)r * ns_)); } while (0)
#define CV_STEP(v, it, bsel, has_n, itn) do { LAS unsigned char* buf = lds + (bsel) * 32768; \
                { float ms[16]; const bool fold = (it) < 2 * NE * 128; const int kr0 = ((it) < NWX ? 128 * (((it) & 127) >> 3) : 0) + 16 * wave; \
                  _Pragma("unroll") for (int r = 0; r < 16; ++r) { const float gq_ = gsc[kr0 + r]; ms[r] = fold ? gq_ : pg8::W_SCALE; } \
                  _Pragma("unroll") for (int j = 0; j < 4; ++j) { u32x4 o; o.x = pg8::pk4_fp8(v[0][j] * ms[0], v[1][j] * ms[1], v[2][j] * ms[2], v[3][j] * ms[3]); o.y = pg8::pk4_fp8(v[4][j] * ms[4], v[5][j] * ms[5], v[6][j] * ms[6], v[7][j] * ms[7]); \
                    o.z = pg8::pk4_fp8(v[8][j] * ms[8], v[9][j] * ms[9], v[10][j] * ms[10], v[11][j] * ms[11]); o.w = pg8::pk4_fp8(v[12][j] * ms[12], v[13][j] * ms[13], v[14][j] * ms[14], v[15][j] * ms[15]); \
                    *(LAS u32x4*)(buf + (n4 + j) * 128 + ((wave ^ (lane & 7)) << 4)) = o; } } \
                const int mat = (it) >> 7, r7 = (it) & 127, which = mat >> 5, e = mat & 31; \
                const int nb = (it) < NWX ? (r7 & 7) : ((it) - NWX) % 24, kg = (it) < NWX ? (r7 >> 3) : ((it) - NWX) / 24; \
                CV_LOAD(v, itn); \
                __syncthreads(); \
                unsigned char* dst = ((it) < NWX ? (which == 0 ? WgT : (which == 1 ? WuT : WdT)) + (size_t)e * DM * DFF : WinG8) + (size_t)(256 * nb) * DM + 128 * kg + 16 * (lane & 7); \
                _Pragma("unroll") for (int q4 = 0; q4 < 4; ++q4) { const int row = wave * 32 + q4 * 8 + (lane >> 3);     \
                    const u32x4 o = *(const LAS u32x4*)(buf + row * 128 + (((lane & 7) ^ ((row >> 2) & 7)) << 4)); *(u32x4*)(dst + (size_t)row * DM) = o; } } while (0)
#define CV_CL(i_) CV_ITEM((i_) < nitems ? (i_) : nitems - 1)
            if (nitems > 0) { CV_LOAD(vA, CV_CL(0)); CV_LOAD(vB, CV_CL(1));
                for (int i = 0; i < nitems; i += 2) {
                    { const int it = CV_CL(i); CV_STEP(vA, it, 0, true, CV_CL(i + 2)); }
                    { const int it = CV_CL(i + 1); CV_STEP(vB, it, 1, true, CV_CL(i + 3)); }
                } }
#undef CV_CL
#undef CV_STEP
#undef CV_LOAD
#undef CV_ITEM
            __syncthreads();
        }
        }
    }
    SEAM(1);

    if (IN(2)) {
        for (int u = vcu; u < 256; u += G) {
            const int bh = u >> 2, jp = u & 3, b = bh >> 3, h = bh & 7;
            const bf16_t* base = Pb + (size_t)b * SEQ * INW + h * 128;
#pragma unroll 1
            for (int s = 0; s < 2; ++s) { const int qb = s ? 7 - jp : jp;
                att::attn_sb_body(base + C_QSB + (size_t)qb * 256 * INW, base + C_KSB, base + C_VSB, INW, MIX + ((size_t)b * SEQ + qb * 256) * DM + 512 + h * 128, DM, qb, (char*)lds_raw); }
        }
        for (int u = vcu; u < 256; u += G) {
            const int b = u >> 5, h = (u >> 3) & 3, qb = u & 7;
            att::attn_dense_body(Pb + ((size_t)b * SEQ + qb * 256) * INW + C_QXA + h * 128, INW, KVXA + (size_t)b * NMEM * 1024 + h * 128, KVXA + (size_t)b * NMEM * 1024 + 512 + h * 128, 1024,
                                 MIX + ((size_t)b * SEQ + qb * 256) * DM + 1536 + h * 128, DM, NMEM, (char*)lds_raw);
        }
#define POOL_GROUP(G_, W_) for (int it = vcu * NTHR + tid; it < T * 16; it += G * NTHR) { const int row = it >> 4, ch = (G_) * 128 + (it & 15) * 8, t = row & (SEQ - 1); \
            u32x4 vv[W_]; _Pragma("unroll") for (int j = 0; j < (W_); ++j) vv[j] = (j <= t) ? *(const u32x4*)(Pb + (size_t)(row - j) * INW + C_POOL + ch) : (u32x4){0u, 0u, 0u, 0u}; \
            float s8[8]; _Pragma("unroll") for (int k = 0; k < 8; ++k) s8[k] = 0.f; \
            _Pragma("unroll") for (int j = 0; j < (W_); ++j) { s8[0] += bf_lo(vv[j].x); s8[1] += bf_hi(vv[j].x); s8[2] += bf_lo(vv[j].y); s8[3] += bf_hi(vv[j].y); s8[4] += bf_lo(vv[j].z); s8[5] += bf_hi(vv[j].z); s8[6] += bf_lo(vv[j].w); s8[7] += bf_hi(vv[j].w); } \
            const float inv = 1.0f / (float)((t + 1 < (W_)) ? t + 1 : (W_)); const u32x4 cur = vv[0]; \
            u32x4 o; o.x = cvt_pk_bf16(s8[0] * inv - bf_lo(cur.x), s8[1] * inv - bf_hi(cur.x)); o.y = cvt_pk_bf16(s8[2] * inv - bf_lo(cur.y), s8[3] * inv - bf_hi(cur.y)); \
            o.z = cvt_pk_bf16(s8[4] * inv - bf_lo(cur.z), s8[5] * inv - bf_hi(cur.z)); o.w = cvt_pk_bf16(s8[6] * inv - bf_lo(cur.w), s8[7] * inv - bf_hi(cur.w)); \
            *(u32x4*)(MIX + (size_t)row * DM + ch) = o; }
        POOL_GROUP(0, 2) POOL_GROUP(1, 4) POOL_GROUP(2, 8) POOL_GROUP(3, 16)
#undef POOL_GROUP
        __syncthreads();
    }
    SEAM(2);

    if (IN(3))
    {
        { pg8::DenseProb P; P.init(MIX, WmixT, T, DM, DM, G, bx); pg8::EpiMix E{(unsigned char*)MERGED, Gate8}; pg8::gemm_phase(lds, P, E); }
    }
    SEAM(3);

    if (IN(4))
    {
        pg8::DenseProb8 P; P.init(MERGED, WoutT, T, DM, DM, G, bx); pg8::EpiResid8 E{x, Hb, H8, 1.0f / (pg8::W_SCALE * pg8::M_SCALE)}; pg8::gemm_phase(lds, P, E);
    }
    SEAM(4);

    if (IN(5)) {
        LAS float* tile = (LAS float*)lds;
        LAS float* ssq = (LAS float*)(lds + 40960);
        LAS int* hist = (LAS int*)(lds + 45056);
        LAS int* sel = (LAS int*)(lds + 45568);
        LAS float* selp = (LAS float*)(lds + 45568 + 2048);
        LAS float* rstd_l = (LAS float*)(lds + 45568 + 3072);
        const float* br = args.in[I_BR];
        const int r32 = lane & 31, hh = lane >> 5, rb = wave & 1, kq = wave >> 1;
        for (int u = vcu; u < T / 64; u += G) {
            const int row0 = u * 64;
            if (tid < 32) hist[tid] = 0;
            f32x16 acc = {}; float ss = 0.f;
            const bf16_t* hrow = Hb + (size_t)(row0 + 32 * rb + r32) * DM;
            const float* wrow = WRT + (size_t)r32 * DM;
            u32x4 qa[4][2]; f32x4 qb[4][4];
#define RT_LOAD(slot, sg_) do { const int kb_ = 512 * kq + 32 * (sg_) + 16 * hh; qa[slot][0] = *(const u32x4*)(hrow + kb_); qa[slot][1] = *(const u32x4*)(hrow + kb_ + 8); \
                _Pragma("unroll") for (int q = 0; q < 4; ++q) qb[slot][q] = *(const f32x4*)(wrow + kb_ + 4 * q); } while (0)
#define RT_MMA(slot) do { _Pragma("unroll") for (int j = 0; j < 16; ++j) { const unsigned w_ = qa[slot][j >> 3][(j >> 1) & 3]; const float av = (j & 1) ? bf_hi(w_) : bf_lo(w_); \
                acc = __builtin_amdgcn_mfma_f32_32x32x2f32(av, qb[slot][j >> 2][j & 3], acc, 0, 0, 0); ss += av * av; } } while (0)
            RT_LOAD(0, 0); RT_LOAD(1, 1); RT_LOAD(2, 2);
#pragma unroll 1
            for (int sg = 0; sg < 16; sg += 4) {
                __builtin_amdgcn_sched_barrier(0); RT_LOAD(3, sg + 3); __builtin_amdgcn_sched_barrier(0); RT_MMA(0);
                __builtin_amdgcn_sched_barrier(0); if (sg + 4 < 16) RT_LOAD(0, sg + 4); __builtin_amdgcn_sched_barrier(0); RT_MMA(1);
                __builtin_amdgcn_sched_barrier(0); if (sg + 5 < 16) RT_LOAD(1, sg + 5); __builtin_amdgcn_sched_barrier(0); RT_MMA(2);
                __builtin_amdgcn_sched_barrier(0); if (sg + 6 < 16) RT_LOAD(2, sg + 6); __builtin_amdgcn_sched_barrier(0); RT_MMA(3);
            }
#undef RT_LOAD
#undef RT_MMA
#pragma unroll
            for (int r = 0; r < 16; ++r) tile[((kq * 2 + rb) * 32 + att::crow(r, hh)) * 33 + r32] = acc[r];
            ssq[((kq * 2 + rb) * 2 + hh) * 32 + r32] = ss;
            __syncthreads();
            if (tid < 64) {
                const int rbb = tid >> 5, r = tid & 31; float sq = 0.f;
#pragma unroll
                for (int q = 0; q < 4; ++q) sq += ssq[((q * 2 + rbb) * 2 + 0) * 32 + r] + ssq[((q * 2 + rbb) * 2 + 1) * 32 + r];
                const float rstd = 1.0f / sqrtf(sq * (1.f / DM) + EPS);
                float lg[NE];
#pragma unroll
                for (int e = 0; e < NE; ++e) { float s = 0.f;
#pragma unroll
                    for (int q = 0; q < 4; ++q) s += tile[((q * 2 + rbb) * 32 + r) * 33 + e];
                    lg[e] = s * rstd + br[e]; }
                int ti[TOPK]; float tv[TOPK];
#pragma unroll
                for (int k = 0; k < TOPK; ++k) { float bv = -3.0e38f; int bi = 0;
#pragma unroll
                    for (int e = 0; e < NE; ++e) { const bool better = lg[e] > bv; bv = better ? lg[e] : bv; bi = better ? e : bi; }
                    ti[k] = bi; tv[k] = bv;
#pragma unroll
                    for (int e = 0; e < NE; ++e) lg[e] = (e == bi) ? -3.0e38f : lg[e]; }
                float pe[TOPK], psum = 0.f;
#pragma unroll
                for (int k = 0; k < TOPK; ++k) { pe[k] = __expf(tv[k] - tv[0]); psum += pe[k]; }
                const float pinv = 1.0f / psum;
#pragma unroll
                for (int k = 0; k < TOPK; ++k) { sel[tid * 4 + k] = ti[k]; sel[256 + tid * 4 + k] = __hip_atomic_fetch_add(&hist[ti[k]], 1, __ATOMIC_RELAXED, __HIP_MEMORY_SCOPE_WORKGROUP); selp[tid * 4 + k] = pe[k] * pinv; }
                rstd_l[tid] = rstd;
            }
            __syncthreads();
            if (tid < 32) { const int c = hist[tid]; hist[32 + tid] = c ? (int)atomicAdd(gcount + tid, (unsigned)c) : 0; }
            __syncthreads();
            if (tid < 64) {
#pragma unroll
                for (int k = 0; k < TOPK; ++k) { const int e = sel[tid * 4 + k]; int rank = hist[32 + e] + sel[256 + tid * 4 + k]; if (rank >= CAP) rank = CAP - 1; const int slot = e * CAP + rank;
                    ROWSTOK[slot] = row0 + tid; GATEW[slot] = selp[tid * 4 + k]; RSTDW[slot] = rstd_l[tid]; TOKSLOT[(row0 + tid) * 4 + k] = slot; }
            }
            __syncthreads();
        }
    }
    SEAM(5);

    if (IN(6))
    {
        build_moe_tables(tab, gcount);
        pg8::MoeProb<16, true> P{H8, WgT, WuT, ROWSTOK, DM, G, vcu, __builtin_amdgcn_readfirstlane(tab[31]), tab, 0};
        pg8::EpiSwiglu E{Act, args.in[I_BGATE], args.in[I_BUP], RSTDW, lds + LDS_EPI};
        pg8::gemm_phase(lds, P, E);
    }
    SEAM(6);

    if (IN(7))
    {
        build_moe_tables(tab, gcount);
        pg8::MoeProb<8, false> P{Act, WdT, WdT, ROWSTOK, DFF, G, vcu, __builtin_amdgcn_readfirstlane(tab[128 + 31]), tab, 128};
        pg8::EpiDown E{Yb, args.in[I_BDOWN], GATEW, lds + LDS_EPI};
        pg8::gemm_phase(lds, P, E);
    }
    SEAM(7);

    if (IN(8)) {
        build_moe_tables(tab, gcount);
        const float* gfin = args.in[I_NFING];
        for (int m = gw; m < T; m += NGW) {
            const unsigned char* yr[TOPK];
#pragma unroll
            for (int k = 0; k < TOPK; ++k) { const int slot = __builtin_amdgcn_readfirstlane(TOKSLOT[m * 4 + k]); const int e = slot >> 14, rank = slot & (CAP - 1); yr[k] = Yb + ((size_t)tab[64 + e] * 256 + rank) * DM; }
            const u32x2* hr = (const u32x2*)(Hb + (size_t)m * DM) + lane; f32x4* xr = (f32x4*)(args.out + (size_t)m * DM) + lane; const f32x4* gr = (const f32x4*)gfin + lane;
            f32x4 v[8]; float s = 0.f; constexpr float IY = 1.0f / pg8::Y_SCALE;
#pragma unroll
            for (int j = 0; j < 8; ++j) { const u32x2 hw = hr[64 * j]; v[j] = (f32x4){bf_lo(hw.x), bf_hi(hw.x), bf_lo(hw.y), bf_hi(hw.y)}; f32x4 ys = {0.f, 0.f, 0.f, 0.f};
#pragma unroll
                for (int k = 0; k < TOPK; ++k) { const unsigned y = *((const unsigned*)yr[k] + lane + 64 * j); const f32x2 lo = __builtin_amdgcn_cvt_pk_f32_fp8((int)y, false), hi2 = __builtin_amdgcn_cvt_pk_f32_fp8((int)y, true);
                    ys.x += lo.x; ys.y += lo.y; ys.z += hi2.x; ys.w += hi2.y; }
                v[j] = v[j] + ys * IY;
                s += (v[j].x * v[j].x + v[j].y * v[j].y) + (v[j].z * v[j].z + v[j].w * v[j].w); }
            const float rstd = 1.0f / sqrtf(wave_sum(s) * (1.f / DM) + EPS);
#pragma unroll
            for (int j = 0; j < 8; ++j) { const f32x4 gg = gr[64 * j]; xr[64 * j] = (f32x4){v[j].x * rstd * gg.x, v[j].y * rstd * gg.y, v[j].z * rstd * gg.z, v[j].w * rstd * gg.w}; }
        }
    }
#undef IN
#undef SEAM
}

extern "C" void kernel_launch(void* const* d_in, const int* in_sizes, int n_in, void* d_out, int out_size, void* d_ws, size_t ws_size, hipStream_t stream) {
    static int grid = 0;
    if (grid == 0) {
        if (n_in != 22 || out_size != T * DM || ws_size < WS_END) { fprintf(stderr, "kernel_launch: unexpected shapes (n_in %d out %d ws %zu need %zu)\n", n_in, out_size, ws_size, (size_t)WS_END); grid = -1; return; }
        int dev = 0, cus = 0, per_cu = 0;
        if (hipGetDevice(&dev) != hipSuccess || hipDeviceGetAttribute(&cus, hipDeviceAttributeMultiprocessorCount, dev) != hipSuccess) { grid = -1; return; }
        if (hipFuncSetAttribute((const void*)fwd, hipFuncAttributeMaxDynamicSharedMemorySize, LDS_BYTES) != hipSuccess) { fprintf(stderr, "kernel_launch: hipFuncSetAttribute failed\n"); grid = -1; return; }
        if (hipOccupancyMaxActiveBlocksPerMultiprocessor(&per_cu, (const void*)fwd, NTHR, LDS_BYTES) != hipSuccess || per_cu < 1) fprintf(stderr, "kernel_launch: occupancy query reports %d\n", per_cu);
        (void)hipGetLastError();
        grid = cus;
    }
    if (grid < 0) return;
    if (hipMemsetAsync((char*)d_ws + WS_CTL, 0, CTL_ZERO_BYTES, stream) != hipSuccess) return;
    Args a{};
    for (int i = 0; i < 22; ++i) a.in[i] = (const float*)d_in[i];
    a.out = (float*)d_out; a.ws = (unsigned char*)d_ws;
    constexpr int NPH = 9;
    if (MK_N_LAUNCHES == 1) { a.ph_lo = 0; a.ph_hi = NPH; hipLaunchKernelGGL(fwd, dim3(grid), dim3(NTHR), LDS_BYTES, stream, a); }
    else for (int p = 0; p < NPH; ++p) { a.ph_lo = p; a.ph_hi = p + 1; hipLaunchKernelGGL(fwd, dim3(grid), dim3(NTHR), LDS_BYTES, stream, a); }
    const hipError_t le = hipPeekAtLastError();
    if (le != hipSuccess) fprintf(stderr, "kernel_launch: launch failed: %s\n", hipGetErrorName(le));
}
```
